# Optimizing an MI355X kernel written in HIP

```python
import jax
import jax.numpy as jnp
from jax import lax
import numpy as np

D_MODEL = 1024
BATCH = 8
SEQ = 2048
DEPTH = 4

N_MEM = 256
EPS = 1e-6
Q_BLOCK = 128
FFN_DIM = 2816

A_HEADS = 4
A_Q_LORA = 384
A_KV_LORA = 256
A_NOPE = 128
A_ROPE = 64
A_V = 128
ROPE_BASE = 10000.0

B_HEADS = 4
B_HEAD_DIM = 128
B_WIDTH = B_HEADS * B_HEAD_DIM
B_CONV = 4
B_CHUNK = 128

C_HEADS = 8
C_Q_LORA = 384
C_KV_LORA = 256
C_NOPE = 128
C_V = 128
IDX_HEADS = 8
IDX_DIM = 64
TOPK_MAX = 256

X_HEADS = 4
X_HEAD_DIM = 128

AB_IN = A_Q_LORA + A_KV_LORA + A_ROPE + 3 * B_WIDTH
AB_SPLITS = (A_Q_LORA, A_Q_LORA + A_KV_LORA, A_Q_LORA + A_KV_LORA + A_ROPE,
             A_Q_LORA + A_KV_LORA + A_ROPE + B_WIDTH, A_Q_LORA + A_KV_LORA + A_ROPE + 2 * B_WIDTH)
AB_MIX = A_HEADS * A_V + B_WIDTH
C_IN = C_Q_LORA + C_KV_LORA + IDX_HEADS * IDX_DIM + IDX_DIM + IDX_HEADS
C_SPLITS = (C_Q_LORA, C_Q_LORA + C_KV_LORA, C_Q_LORA + C_KV_LORA + IDX_HEADS * IDX_DIM,
            C_Q_LORA + C_KV_LORA + IDX_HEADS * IDX_DIM + IDX_DIM)
N_EVEN = (DEPTH + 1) // 2
N_ODD = DEPTH // 2

kernel_name = 'hybrid_mla_mlstm_dsa_macaron'


def rmsnorm(x, g):
    xf = x.astype(jnp.float32)
    y = xf * lax.rsqrt(jnp.mean(xf * xf, -1, keepdims=True) + EPS)
    return (y * g.astype(jnp.float32)).astype(x.dtype)


def swiglu(x, wg, wu, wd):
    return (jax.nn.silu(x @ wg) * (x @ wu)) @ wd


def rope(x, positions):
    half = x.shape[-1] // 2
    inv = ROPE_BASE ** (-jnp.arange(half, dtype=jnp.float32) / half)
    ang = positions.astype(jnp.float32)[..., None] * inv
    ang = ang.reshape(ang.shape[:2] + (1,) * (x.ndim - 3) + (half,))
    cos, sin = jnp.cos(ang), jnp.sin(ang)
    xf = x.astype(jnp.float32)
    x1, x2 = xf[..., :half], xf[..., half:]
    return jnp.concatenate([x1 * cos - x2 * sin, x1 * sin + x2 * cos], -1).astype(x.dtype)


def causal_block_attention(q, k, v, scale):
    seq = q.shape[2]
    tri = jnp.tril(jnp.ones((Q_BLOCK, Q_BLOCK), bool))
    outs = []
    for i0 in range(0, seq, Q_BLOCK):
        end = i0 + Q_BLOCK
        s = jnp.einsum('bhqd,bhkd->bhqk', q[:, :, i0:end], k[:, :, :end]).astype(jnp.float32) * scale
        mask = jnp.concatenate([jnp.ones((Q_BLOCK, i0), bool), tri], axis=1)
        p = jax.nn.softmax(jnp.where(mask, s, -jnp.inf), axis=-1).astype(v.dtype)
        outs.append(jnp.einsum('bhqk,bhkd->bhqd', p, v[:, :, :end]))
    return jnp.concatenate(outs, axis=2)


def mla_mixer(cq, ckv, kr, positions, cq_g, ckv_g, w_uq, w_ukv):
    b, s, _ = cq.shape
    q = (rmsnorm(cq, cq_g) @ w_uq).reshape(b, s, A_HEADS, A_NOPE + A_ROPE)
    q_nope, q_rope = q[..., :A_NOPE], rope(q[..., A_NOPE:], positions)
    kv = (rmsnorm(ckv, ckv_g) @ w_ukv).reshape(b, s, A_HEADS, A_NOPE + A_V)
    k_nope, v = kv[..., :A_NOPE], kv[..., A_NOPE:]
    k_rope = jnp.broadcast_to(rope(kr, positions)[:, :, None, :], (b, s, A_HEADS, A_ROPE))
    qf = jnp.concatenate([q_nope, q_rope], -1).transpose(0, 2, 1, 3)
    kf = jnp.concatenate([k_nope, k_rope], -1).transpose(0, 2, 1, 3)
    o = causal_block_attention(qf, kf, v.transpose(0, 2, 1, 3), (A_NOPE + A_ROPE) ** -0.5)
    return o.transpose(0, 2, 1, 3).reshape(b, s, A_HEADS * A_V)


def causal_dwconv(x, w, bias):
    y = lax.conv_general_dilated(x, w[:, None, :], window_strides=(1,), padding=[(B_CONV - 1, 0)],
                                 dimension_numbers=('NWC', 'WIO', 'NWC'), feature_group_count=x.shape[-1])
    return y + bias


def mlstm_chunkwise(q, k, v, li, lf):
    b, h, s, d = q.shape
    nc = s // B_CHUNK

    def to_chunks(t):
        return jnp.moveaxis(t.reshape((b, h, nc, B_CHUNK) + t.shape[3:]), 2, 0)

    causal = jnp.tril(jnp.ones((B_CHUNK, B_CHUNK), bool))

    def step(carry, inp):
        c_st, n_st, m_st = carry
        qj, kj, vj, lij, lfj = inp
        bcum = jnp.cumsum(lfj, -1)
        dmat = bcum[..., :, None] - bcum[..., None, :] + lij[..., None, :]
        dmat = jnp.where(causal, dmat, -jnp.inf)
        m_inter = bcum + m_st[..., None]
        m_j = jnp.maximum(m_inter, jnp.max(dmat, -1))
        sc = jnp.einsum('bhld,bhsd->bhls', qj, kj) * jnp.exp(dmat - m_j[..., None])
        inter = jnp.exp(m_inter - m_j)
        num = inter[..., None] * jnp.einsum('bhld,bhdv->bhlv', qj, c_st) + jnp.einsum('bhls,bhsv->bhlv', sc, vj)
        den = inter * jnp.einsum('bhld,bhd->bhl', qj, n_st) + jnp.sum(sc, -1)
        hj = num / jnp.maximum(jnp.abs(den), jnp.exp(-m_j))[..., None]
        b_tot = bcum[..., -1]
        g = b_tot[..., None] - bcum + lij
        m_new = jnp.maximum(b_tot + m_st, jnp.max(g, -1))
        decay = jnp.exp(b_tot + m_st - m_new)
        wg = jnp.exp(g - m_new[..., None])
        c_new = decay[..., None, None] * c_st + jnp.einsum('bhs,bhsd,bhsv->bhdv', wg, kj, vj)
        n_new = decay[..., None] * n_st + jnp.einsum('bhs,bhsd->bhd', wg, kj)
        return (c_new, n_new, m_new), hj

    init = (jnp.zeros((b, h, d, d), jnp.float32), jnp.zeros((b, h, d), jnp.float32),
            jnp.zeros((b, h), jnp.float32))
    _, hs = lax.scan(step, init, (to_chunks(q), to_chunks(k), to_chunks(v), to_chunks(li), to_chunks(lf)))
    return jnp.moveaxis(hs, 0, 2).reshape(b, h, s, d)


def mlstm_mixer(xm, vm, og, conv_w, conv_b, wq, wk, w_gates, b_gates, gn_g, skip):
    b, s, _ = xm.shape
    xc = jax.nn.silu(causal_dwconv(xm, conv_w, conv_b))
    xch = xc.reshape(b, s, B_HEADS, B_HEAD_DIM)
    q = jnp.einsum('bshd,hde->bshe', xch, wq)
    k = jnp.einsum('bshd,hde->bshe', xch, wk)
    gates = (jnp.concatenate([q.reshape(b, s, B_WIDTH), k.reshape(b, s, B_WIDTH), vm], -1) @ w_gates
             + b_gates).astype(jnp.float32)
    li = gates[..., :B_HEADS]
    lf = jax.nn.log_sigmoid(gates[..., B_HEADS:])
    to_bhs = lambda t: jnp.moveaxis(t.astype(jnp.float32), 2, 1)
    hh = mlstm_chunkwise(to_bhs(q), to_bhs(k) * B_HEAD_DIM ** -0.5,
                         to_bhs(vm.reshape(b, s, B_HEADS, B_HEAD_DIM)), to_bhs(li), to_bhs(lf))
    mu = jnp.mean(hh, -1, keepdims=True)
    var = jnp.mean(jnp.square(hh - mu), -1, keepdims=True)
    hn = ((hh - mu) * lax.rsqrt(var + EPS)).transpose(0, 2, 1, 3).reshape(b, s, B_WIDTH)
    out = ((hn * gn_g.astype(jnp.float32) + skip.astype(jnp.float32) * xc.astype(jnp.float32))
           * jax.nn.sigmoid(og.astype(jnp.float32)))
    return out.astype(xm.dtype)


def dsa_mixer(h, w_in, cq_g, ckv_g, w_uq, w_uk, w_uv):
    b, s, _ = h.shape
    cq, ckv, qi, ki, wi = jnp.split(h @ w_in, C_SPLITS, axis=-1)
    q = (rmsnorm(cq, cq_g) @ w_uq).reshape(b, s, C_HEADS, C_NOPE)
    ckv = rmsnorm(ckv, ckv_g)
    q_lat = jnp.einsum('bshd,hcd->bshc', q, w_uk)
    qi = qi.reshape(b, s, IDX_HEADS, IDX_DIM)
    topk = min(TOPK_MAX, s // 4)
    scale = C_NOPE ** -0.5
    outs = []
    for i0 in range(0, s, Q_BLOCK):
        end = i0 + Q_BLOCK
        kk = min(topk, end)
        t_pos = jnp.arange(i0, end)
        admissible = jnp.arange(end)[None, :] <= t_pos[:, None]
        rel = jax.nn.relu(jnp.einsum('bthd,bsd->bths', qi[:, i0:end], ki[:, :end]))
        score = jnp.einsum('bths,bth->bts', rel, wi[:, i0:end]).astype(jnp.float32)
        _, idx = lax.top_k(jnp.where(admissible, score, -jnp.inf), kk)
        valid = idx <= t_pos[None, :, None]
        c_sel = jax.vmap(lambda c, i: c[i])(ckv[:, :end], idx)
        logits = jnp.einsum('bthc,btkc->bthk', q_lat[:, i0:end], c_sel).astype(jnp.float32) * scale
        p = jax.nn.softmax(jnp.where(valid[:, :, None, :], logits, -jnp.inf), -1).astype(c_sel.dtype)
        outs.append(jnp.einsum('bthk,btkc->bthc', p, c_sel))
    o_lat = jnp.concatenate(outs, 1)
    return jnp.einsum('bshc,hcv->bshv', o_lat, w_uv).reshape(b, s, C_HEADS * C_V)


def memory_cross_attention(h, mem_n, wq, wk, wv, wo):
    b, s, _ = h.shape
    q = (h @ wq).reshape(b, s, X_HEADS, X_HEAD_DIM)
    k = (mem_n @ wk).reshape(b, -1, X_HEADS, X_HEAD_DIM)
    v = (mem_n @ wv).reshape(b, -1, X_HEADS, X_HEAD_DIM)
    logits = jnp.einsum('bshd,bmhd->bhsm', q, k).astype(jnp.float32) * X_HEAD_DIM ** -0.5
    p = jax.nn.softmax(logits, -1).astype(v.dtype)
    return jnp.einsum('bhsm,bmhd->bshd', p, v).reshape(b, s, X_HEADS * X_HEAD_DIM) @ wo


def setup_inputs(seed: int = 0) -> dict:
    key = jax.random.key(seed)
    ks = iter(jax.random.split(key, 64))
    f32 = jnp.float32
    nrm = lambda shape, fan_in: jax.random.normal(next(ks), shape, f32) * fan_in ** -0.5
    gain = lambda shape: 1.0 + 0.05 * jax.random.normal(next(ks), shape, f32)
    small = lambda shape: 0.02 * jax.random.normal(next(ks), shape, f32)
    x = jax.random.normal(next(ks), (BATCH, SEQ, D_MODEL), f32)
    mem = jax.random.normal(next(ks), (BATCH, N_MEM, D_MODEL), f32)
    positions = (jax.random.randint(next(ks), (BATCH, 1), 0, 1024, jnp.int32)
                 + jnp.arange(SEQ, dtype=jnp.int32)[None, :])
    b_gates = jnp.concatenate([
        0.1 * jax.random.normal(next(ks), (N_EVEN, B_HEADS), f32),
        jnp.linspace(3.0, 6.0, B_HEADS, dtype=f32)[None, :]
        + 0.1 * jax.random.normal(next(ks), (N_EVEN, B_HEADS), f32)], axis=-1)
    return {
        'x': x,
        'mem': mem,
        'positions': positions,
        'norm_g': gain((DEPTH, 8, D_MODEL)),
        'mem_norm_g': gain((DEPTH, D_MODEL)),
        'ffn_w_gate': nrm((DEPTH, 2, D_MODEL, FFN_DIM), D_MODEL),
        'ffn_w_up': nrm((DEPTH, 2, D_MODEL, FFN_DIM), D_MODEL),
        'ffn_w_down': nrm((DEPTH, 2, FFN_DIM, D_MODEL), FFN_DIM),
        'xa_wq': nrm((DEPTH, D_MODEL, X_HEADS * X_HEAD_DIM), D_MODEL),
        'xa_wk': nrm((DEPTH, D_MODEL, X_HEADS * X_HEAD_DIM), D_MODEL),
        'xa_wv': nrm((DEPTH, D_MODEL, X_HEADS * X_HEAD_DIM), D_MODEL),
        'xa_wo': nrm((DEPTH, X_HEADS * X_HEAD_DIM, D_MODEL), X_HEADS * X_HEAD_DIM),
        'ab_w_in': nrm((N_EVEN, D_MODEL, AB_IN), D_MODEL),
        'ab_w_out': nrm((N_EVEN, AB_MIX, D_MODEL), AB_MIX),
        'mla_cq_g': gain((N_EVEN, A_Q_LORA)),
        'mla_ckv_g': gain((N_EVEN, A_KV_LORA)),
        'mla_w_uq': nrm((N_EVEN, A_Q_LORA, A_HEADS * (A_NOPE + A_ROPE)), A_Q_LORA),
        'mla_w_ukv': nrm((N_EVEN, A_KV_LORA, A_HEADS * (A_NOPE + A_V)), A_KV_LORA),
        'ml_conv_w': nrm((N_EVEN, B_CONV, B_WIDTH), B_CONV),
        'ml_conv_b': small((N_EVEN, B_WIDTH)),
        'ml_wq': nrm((N_EVEN, B_HEADS, B_HEAD_DIM, B_HEAD_DIM), B_HEAD_DIM),
        'ml_wk': nrm((N_EVEN, B_HEADS, B_HEAD_DIM, B_HEAD_DIM), B_HEAD_DIM),
        'ml_w_gates': nrm((N_EVEN, 3 * B_WIDTH, 2 * B_HEADS), 3 * B_WIDTH),
        'ml_b_gates': b_gates,
        'ml_gn_g': gain((N_EVEN, B_WIDTH)),
        'ml_skip': gain((N_EVEN, B_WIDTH)),
        'c_w_in': nrm((N_ODD, D_MODEL, C_IN), D_MODEL),
        'c_w_out': nrm((N_ODD, C_HEADS * C_V, D_MODEL), C_HEADS * C_V),
        'c_cq_g': gain((N_ODD, C_Q_LORA)),
        'c_ckv_g': gain((N_ODD, C_KV_LORA)),
        'c_w_uq': nrm((N_ODD, C_Q_LORA, C_HEADS * C_NOPE), C_Q_LORA),
        'c_w_uk': nrm((N_ODD, C_HEADS, C_KV_LORA, C_NOPE), C_KV_LORA),
        'c_w_uv': nrm((N_ODD, C_HEADS, C_KV_LORA, C_V), C_KV_LORA),
    }


def reference(x, mem, positions, norm_g, mem_norm_g, ffn_w_gate, ffn_w_up, ffn_w_down,
              xa_wq, xa_wk, xa_wv, xa_wo, ab_w_in, ab_w_out, mla_cq_g, mla_ckv_g, mla_w_uq, mla_w_ukv,
              ml_conv_w, ml_conv_b, ml_wq, ml_wk, ml_w_gates, ml_b_gates, ml_gn_g, ml_skip,
              c_w_in, c_w_out, c_cq_g, c_ckv_g, c_w_uq, c_w_uk, c_w_uv):
    for l in range(DEPTH):
        g = norm_g[l]
        h = rmsnorm(x, g[0])
        x = x + 0.5 * rmsnorm(swiglu(h, ffn_w_gate[l, 0], ffn_w_up[l, 0], ffn_w_down[l, 0]), g[1])
        h = rmsnorm(x, g[2])
        if l % 2 == 0:
            e = l // 2
            cq, ckv, kr, xm, vm, og = jnp.split(h @ ab_w_in[e], AB_SPLITS, axis=-1)
            ya = mla_mixer(cq, ckv, kr, positions, mla_cq_g[e], mla_ckv_g[e], mla_w_uq[e], mla_w_ukv[e])
            yb = mlstm_mixer(xm, vm, og, ml_conv_w[e], ml_conv_b[e], ml_wq[e], ml_wk[e],
                             ml_w_gates[e], ml_b_gates[e], ml_gn_g[e], ml_skip[e])
            y = jnp.concatenate([ya, yb], axis=-1) @ ab_w_out[e]
        else:
            o = l // 2
            y = dsa_mixer(h, c_w_in[o], c_cq_g[o], c_ckv_g[o], c_w_uq[o], c_w_uk[o], c_w_uv[o]) @ c_w_out[o]
        x = x + rmsnorm(y, g[3])
        h = rmsnorm(x, g[4])
        y = memory_cross_attention(h, rmsnorm(mem, mem_norm_g[l]), xa_wq[l], xa_wk[l], xa_wv[l], xa_wo[l])
        x = x + rmsnorm(y, g[5])
        h = rmsnorm(x, g[6])
        x = x + 0.5 * rmsnorm(swiglu(h, ffn_w_gate[l, 1], ffn_w_up[l, 1], ffn_w_down[l, 1]), g[7])
    return x
```

```cpp
#include <hip/hip_runtime.h>
#include <cstdio>
#include <cstdint>
namespace pg8 {
#define PG8_LAS __attribute__((address_space(3)))
typedef unsigned short bf16_t;
typedef short bf16x8 __attribute__((ext_vector_type(8)));
typedef float f32x4 __attribute__((ext_vector_type(4)));
typedef unsigned u32x4 __attribute__((ext_vector_type(4)));
constexpr int BM = 256, BK = 64, HALF = 128, HTB = HALF * BK * 2  , STAGE_BYTES = 8 * HTB, NXCD = 8, WGM = 8;

__host__ __device__ __forceinline__ int lds_byte(int r, int c) { const int st = (r >> 4) * 2 + (c >> 5), rr = r & 15, cc = c & 31, ob = rr * 64 + cc * 2; return st * 1024 + (ob ^ (((ob >> 9) & 1) << 5)); }
__host__ __device__ __forceinline__ void stage_rc(int b, int& R, int& C) { const int st = b / 1024, sb = b % 1024, swz = sb ^ (((sb >> 9) & 1) << 5); R = (st >> 1) * 16 + swz / 64; C = (st & 1) * 32 + (swz % 64) / 2; }
__host__ __device__ __forceinline__ int perm32(int rho) { const int n = rho >> 4, i = rho & 15; return 8 * (i >> 2) + 4 * n + (i & 3); }

struct Unit { int pm, pn; };
struct Gemm { const bf16_t* A; const bf16_t* Bt; int M, N, K; };

struct StaticOrder {
    int nM, nN, nwg, G, c;
    __host__ __device__ void init(int M, int N, int G_, int c_) { nM = M / BM; nN = N / BM; nwg = nM * nN; G = G_; c = c_; }
    __host__ __device__ bool next(int i, Unit& u) const {
        const long L = (long)i * G + c; if (L >= nwg) return false;
        int wgid = (int)L; { const int q = nwg / NXCD, r = nwg % NXCD, xcd = wgid % NXCD, off = wgid / NXCD; wgid = (xcd < r ? xcd * (q + 1) : r * (q + 1) + (xcd - r) * q) + off; }
        const int nig = WGM * nN, gid = wgid / nig, fm = gid * WGM, gsz = (nM - fm) < WGM ? (nM - fm) : WGM;
        u.pm = fm + ((wgid % nig) % gsz); u.pn = (wgid % nig) / gsz; return true;
    }
    __device__ __forceinline__ void a_ready(const Unit&) const {}
    __device__ __forceinline__ void done(const Unit&) const {}
};
__device__ __forceinline__ unsigned cvt_pk_bf16(float lo, float hi) { unsigned r; asm volatile("v_cvt_pk_bf16_f32 %0, %1, %2" : "=v"(r) : "v"(lo), "v"(hi)); return r; }
typedef float f32x2 __attribute__((ext_vector_type(2)));
typedef float f32x2 __attribute__((ext_vector_type(2)));
struct EpiPlain {
    static constexpr bool PERM = true, AFTER_DRAIN = false;
    bf16_t* O; int ldc; float scale;
    __device__ __forceinline__ void operator()(const f32x4 (&acc)[2][2][4][2], const Unit& u, int wr, int wc, int fr_, int fq_) const {
        int ln_; asm volatile("v_mbcnt_lo_u32_b32 %0, -1, 0\n\tv_mbcnt_hi_u32_b32 %0, -1, %0" : "=v"(ln_)); const int fr = ln_ & 15, fq = ln_ >> 4;
        const int row0 = u.pm * BM + wr * 64 + fr, col0 = u.pn * BM + wc * 32 + 8 * fq;
#pragma unroll
        for (int ai = 0; ai < 2; ++ai)
#pragma unroll
            for (int m = 0; m < 4; ++m) { bf16_t* rowp = O + (size_t)(row0 + ai * HALF + m * 16) * ldc + col0;
#pragma unroll
                for (int bj = 0; bj < 2; ++bj) { const f32x4 v0 = acc[ai][bj][m][0] * scale, v1 = acc[ai][bj][m][1] * scale;
                    u32x4 w; w.x = cvt_pk_bf16(v0[0], v0[1]); w.y = cvt_pk_bf16(v0[2], v0[3]); w.z = cvt_pk_bf16(v1[0], v1[1]); w.w = cvt_pk_bf16(v1[2], v1[3]);
                    *(u32x4*)(rowp + bj * HALF) = w; } }
    }
};
__device__ __forceinline__ float silu_mul(float g, float u) { return g * u * __builtin_amdgcn_rcpf(1.0f + __builtin_amdgcn_exp2f(-1.4426950408889634f * g)); }
struct EpiSwiglu {
    static constexpr bool PERM = true, AFTER_DRAIN = false;
    bf16_t* O; int ldc;
    __device__ __forceinline__ void operator()(const f32x4 (&acc)[2][2][4][2], const Unit& u, int wr, int wc, int fr_, int fq_) const {
        int ln_; asm volatile("v_mbcnt_lo_u32_b32 %0, -1, 0\n\tv_mbcnt_hi_u32_b32 %0, -1, %0" : "=v"(ln_)); const int fr = ln_ & 15, fq = ln_ >> 4;
        const int row0 = u.pm * BM + wr * 64 + fr, col0 = u.pn * HALF + wc * 32 + 8 * fq;
#pragma unroll
        for (int ai = 0; ai < 2; ++ai)
#pragma unroll
            for (int m = 0; m < 4; ++m) { bf16_t* rowp = O + (size_t)(row0 + ai * HALF + m * 16) * ldc + col0;
                const f32x4 g0 = acc[ai][0][m][0], g1 = acc[ai][0][m][1], u0 = acc[ai][1][m][0], u1 = acc[ai][1][m][1];
                u32x4 w; w.x = cvt_pk_bf16(silu_mul(g0[0], u0[0]), silu_mul(g0[1], u0[1])); w.y = cvt_pk_bf16(silu_mul(g0[2], u0[2]), silu_mul(g0[3], u0[3]));
                w.z = cvt_pk_bf16(silu_mul(g1[0], u1[0]), silu_mul(g1[1], u1[1])); w.w = cvt_pk_bf16(silu_mul(g1[2], u1[2]), silu_mul(g1[3], u1[3]));
                *(u32x4*)rowp = w; }
    }
};
struct EpiRopeQ {
    static constexpr bool PERM = true, AFTER_DRAIN = false;
    bf16_t* O; int ldc; float scale; const float* rope;
    __device__ __forceinline__ void operator()(const f32x4 (&acc)[2][2][4][2], const Unit& u, int wr, int wc, int fr_, int fq_) const {
        int ln_; asm volatile("v_mbcnt_lo_u32_b32 %0, -1, 0\n\tv_mbcnt_hi_u32_b32 %0, -1, %0" : "=v"(ln_)); const int fr = ln_ & 15, fq = ln_ >> 4;
        const int row0 = u.pm * BM + wr * 64 + fr, col0 = u.pn * BM + wc * 32 + 8 * fq;
#pragma unroll
        for (int ai = 0; ai < 2; ++ai)
#pragma unroll
            for (int m = 0; m < 4; ++m) { const int row = row0 + ai * HALF + m * 16; bf16_t* rowp = O + (size_t)row * ldc + col0;
#pragma unroll
                for (int bj = 0; bj < 2; ++bj) { f32x4 v0 = acc[ai][bj][m][0] * scale, v1 = acc[ai][bj][m][1] * scale;
                    const int w192 = (col0 + bj * HALF) % 192;
                    if (w192 >= 128) { const float* cs = rope + ((size_t)row * 32 + ((w192 - 128) >> 1)) * 2; const f32x4 c0 = *(const f32x4*)cs, c1 = *(const f32x4*)(cs + 4);
                        const f32x4 r0 = {v0[0] * c0[0] - v0[1] * c0[1], v0[0] * c0[1] + v0[1] * c0[0], v0[2] * c0[2] - v0[3] * c0[3], v0[2] * c0[3] + v0[3] * c0[2]};
                        const f32x4 r1 = {v1[0] * c1[0] - v1[1] * c1[1], v1[0] * c1[1] + v1[1] * c1[0], v1[2] * c1[2] - v1[3] * c1[3], v1[2] * c1[3] + v1[3] * c1[2]};
                        v0 = r0; v1 = r1; }
                    u32x4 w; w.x = cvt_pk_bf16(v0[0], v0[1]); w.y = cvt_pk_bf16(v0[2], v0[3]); w.z = cvt_pk_bf16(v1[0], v1[1]); w.w = cvt_pk_bf16(v1[2], v1[3]);
                    *(u32x4*)(rowp + bj * HALF) = w; } }
    }
};
template <class Epi, class Sched, bool ALIGN_EPI = false, bool SP2 = false>
__device__ __forceinline__ void gemm_phase(PG8_LAS unsigned char* lds, const Gemm g, const Sched& S, const Epi& E, const int wave_in) {
    int tid_o; asm volatile("v_mbcnt_lo_u32_b32 %0, -1, 0\n\tv_mbcnt_hi_u32_b32 %0, -1, %0" : "=v"(tid_o)); tid_o += 64 * wave_in; const int tid = tid_o, wid = __builtin_amdgcn_readfirstlane(tid >> 6), lane = tid & 63, wr = wid >> 2, wc = wid & 3, fr = lane & 15, fq = lane >> 4;
    const int K = g.K, nt = K / BK;
    unsigned voffA[2], voffB[2];
#pragma unroll
    for (int i = 0; i < 2; ++i) { int R, C; stage_rc(tid * 16 + i * 8192, R, C); const int Rb = Epi::PERM ? ((R & ~31) + perm32(R & 31)) : R;
        voffA[i] = (unsigned)(R * K + C) * 2u; voffB[i] = (unsigned)(Rb * K + C) * 2u; }
    const size_t kstep = (size_t)(BK * 2);
    const size_t hstep = (size_t)HALF * K * 2;
    const size_t tstep = 2 * hstep;
    const unsigned ldsw = (unsigned)wid * 1024u;
    const int aoff = lds_byte(wr * 64 + fr, fq * 8), boff = lds_byte(wc * 32 + fr, fq * 8);
#define PG8_SA(b, h) (((b) * 2 + (h)) * HTB)
#define PG8_SB(b, h) ((4 + (b) * 2 + (h)) * HTB)
#define PG8_STAGE(bufoff, gbase, voff) do { _Pragma("unroll") for (int _i = 0; _i < 2; ++_i) \
        __builtin_amdgcn_global_load_lds((const unsigned*)((const char*)(gbase) + (voff)[_i]), (PG8_LAS unsigned*)(lds + (bufoff) + ldsw + _i * 8192), 16, 0, 0); } while (0)
#define PG8_LDA(dst, b, h) do { _Pragma("unroll") for (int m = 0; m < 4; ++m) _Pragma("unroll") for (int k = 0; k < 2; ++k) dst[m][k] = *(const PG8_LAS bf16x8*)(lds + PG8_SA(b, h) + aoff + m * 2048 + k * 1024); } while (0)
#define PG8_LDB(dst, b, h) do { _Pragma("unroll") for (int n = 0; n < 2; ++n) _Pragma("unroll") for (int k = 0; k < 2; ++k) dst[n][k] = *(const PG8_LAS bf16x8*)(lds + PG8_SB(b, h) + boff + n * 2048 + k * 1024); } while (0)
#define PG8_MMA(ai, bj, At, Bt) do { __builtin_amdgcn_s_setprio(1); _Pragma("unroll") for (int m = 0; m < 4; ++m) _Pragma("unroll") for (int n = 0; n < 2; ++n) _Pragma("unroll") for (int k = 0; k < 2; ++k) \
        acc[ai][bj][m][n] = __builtin_amdgcn_mfma_f32_16x16x32_bf16(Bt[n][k], At[m][k], acc[ai][bj][m][n], 0, 0, 0); __builtin_amdgcn_s_setprio(0); } while (0)
#define PG8_WAIT_V(n) asm volatile("s_waitcnt vmcnt(" #n ")" ::: "memory")
#define PG8_WAIT_L(n) asm volatile("s_waitcnt lgkmcnt(" #n ")" ::: "memory")
#define PG8_BAR __builtin_amdgcn_s_barrier()
#define PG8_SCHED __builtin_amdgcn_sched_barrier(0)
    Unit cur, nxt; int ui = 0;
    if (!S.next(0, cur)) return;
    f32x4 acc[2][2][4][2];
#pragma unroll
    for (int a = 0; a < 2; ++a)
#pragma unroll
        for (int b = 0; b < 2; ++b)
#pragma unroll
            for (int m = 0; m < 4; ++m)
#pragma unroll
                for (int n = 0; n < 2; ++n) acc[a][b][m][n] = (f32x4){0.f, 0.f, 0.f, 0.f};
    bf16x8 At[4][2], B0[2][2], B1[2][2];
    const char* cA = (const char*)g.A + (size_t)cur.pm * tstep; const char* cB = (const char*)g.Bt + (size_t)cur.pn * tstep;
    S.a_ready(cur);
    if constexpr (SP2) {
        PG8_STAGE(PG8_SB(0, 0), cB, voffB); PG8_STAGE(PG8_SB(0, 1), cB + hstep, voffB); PG8_STAGE(PG8_SA(0, 0), cA, voffA); PG8_STAGE(PG8_SA(0, 1), cA + hstep, voffA);
        if (wr == 1) PG8_BAR;
        PG8_WAIT_V(2); PG8_BAR;
        PG8_STAGE(PG8_SB(1, 0), cB + kstep, voffB); PG8_STAGE(PG8_SA(1, 0), cA + kstep, voffA); PG8_STAGE(PG8_SB(1, 1), cB + hstep + kstep, voffB);
        PG8_WAIT_V(6); PG8_BAR;
    } else {
        PG8_STAGE(PG8_SB(0, 0), cB, voffB); PG8_STAGE(PG8_SA(0, 0), cA, voffA); PG8_STAGE(PG8_SB(0, 1), cB + hstep, voffB); PG8_STAGE(PG8_SA(0, 1), cA + hstep, voffA);
        if (wr == 1) PG8_BAR;
        PG8_WAIT_V(4); PG8_BAR;
        PG8_STAGE(PG8_SB(1, 0), cB + kstep, voffB); PG8_STAGE(PG8_SA(1, 0), cA + kstep, voffA); PG8_STAGE(PG8_SB(1, 1), cB + hstep + kstep, voffB);
        PG8_WAIT_V(6); PG8_BAR;
    }
    for (;;) {
        const bool has_next = S.next(ui + 1, nxt);
        const char* nA = has_next ? (const char*)g.A + (size_t)nxt.pm * tstep : cA; const char* nB = has_next ? (const char*)g.Bt + (size_t)nxt.pn * tstep : cB;
        for (int t = 0; t < nt; t += 2) {
            const bool last = (t == nt - 2);
            const char* a1 = cA + (size_t)(t + 1) * kstep;
            const char* a2 = last ? nA : cA + (size_t)(t + 2) * kstep; const char* b2 = last ? nB : cB + (size_t)(t + 2) * kstep;
            const char* a3 = a2 + kstep; const char* b3 = b2 + kstep;
            if (last && has_next) S.a_ready(nxt);
            if constexpr (SP2) {
            PG8_LDB(B0, 0, 0); PG8_LDB(B1, 0, 1); PG8_SCHED; PG8_LDA(At, 0, 0); PG8_STAGE(PG8_SA(1, 1), a1 + hstep, voffA);
            PG8_WAIT_V(8); PG8_WAIT_L(0); PG8_BAR; PG8_MMA(0, 0, At, B0); PG8_MMA(0, 1, At, B1); PG8_BAR; PG8_SCHED;
            PG8_LDA(At, 0, 1); PG8_STAGE(PG8_SB(0, 0), b2, voffB); PG8_STAGE(PG8_SB(0, 1), b2 + hstep, voffB); PG8_STAGE(PG8_SA(0, 0), a2, voffA);
            PG8_WAIT_V(8); PG8_WAIT_L(0); PG8_BAR; PG8_MMA(1, 0, At, B0); PG8_MMA(1, 1, At, B1); PG8_BAR; PG8_SCHED;
            PG8_LDB(B0, 1, 0); PG8_LDB(B1, 1, 1); PG8_SCHED; PG8_LDA(At, 1, 0); PG8_STAGE(PG8_SA(0, 1), a2 + hstep, voffA);
            PG8_WAIT_V(8); PG8_WAIT_L(0); PG8_BAR; PG8_MMA(0, 0, At, B0); PG8_MMA(0, 1, At, B1); PG8_BAR; PG8_SCHED;
            PG8_LDA(At, 1, 1); PG8_STAGE(PG8_SB(1, 0), b3, voffB); PG8_STAGE(PG8_SB(1, 1), b3 + hstep, voffB); PG8_STAGE(PG8_SA(1, 0), a3, voffA);
            PG8_WAIT_V(8); PG8_WAIT_L(0); PG8_BAR; PG8_MMA(1, 0, At, B0); PG8_MMA(1, 1, At, B1); PG8_BAR; PG8_SCHED;
            } else {
            PG8_LDB(B0, 0, 0); PG8_SCHED; PG8_LDA(At, 0, 0); PG8_STAGE(PG8_SA(1, 1), a1 + hstep, voffA);
            PG8_WAIT_L(8); PG8_BAR; PG8_WAIT_L(0); PG8_MMA(0, 0, At, B0); PG8_BAR; PG8_SCHED;
            PG8_LDB(B1, 0, 1); PG8_STAGE(PG8_SB(0, 0), b2, voffB);
            PG8_BAR; PG8_WAIT_L(0); PG8_MMA(0, 1, At, B1); PG8_BAR;
            PG8_LDA(At, 0, 1); PG8_STAGE(PG8_SA(0, 0), a2, voffA);
            PG8_BAR; PG8_WAIT_L(0); PG8_MMA(1, 0, At, B0); PG8_BAR; PG8_SCHED;
            PG8_STAGE(PG8_SB(0, 1), b2 + hstep, voffB);
            PG8_WAIT_V(6); PG8_BAR; PG8_MMA(1, 1, At, B1); PG8_BAR;
            PG8_LDB(B0, 1, 0); PG8_SCHED; PG8_LDA(At, 1, 0); PG8_STAGE(PG8_SA(0, 1), a2 + hstep, voffA);
            PG8_WAIT_L(8); PG8_BAR; PG8_WAIT_L(0); PG8_MMA(0, 0, At, B0); PG8_BAR; PG8_SCHED;
            PG8_LDB(B1, 1, 1); PG8_STAGE(PG8_SB(1, 0), b3, voffB);
            PG8_BAR; PG8_WAIT_L(0); PG8_MMA(0, 1, At, B1); PG8_BAR;
            PG8_LDA(At, 1, 1); PG8_STAGE(PG8_SA(1, 0), a3, voffA);
            PG8_BAR; PG8_WAIT_L(0); PG8_MMA(1, 0, At, B0); PG8_BAR; PG8_SCHED;
            PG8_STAGE(PG8_SB(1, 1), b3 + hstep, voffB);
            PG8_WAIT_V(6); PG8_BAR; PG8_MMA(1, 1, At, B1); PG8_BAR;
            }
        }
        if constexpr (ALIGN_EPI) { if (wr == 0) PG8_BAR; }
        if constexpr (!Epi::AFTER_DRAIN) { E(acc, cur, wr, wc, fr, fq); S.done(cur); }
        if (!has_next) break;
#pragma unroll
        for (int a = 0; a < 2; ++a)
#pragma unroll
            for (int b = 0; b < 2; ++b)
#pragma unroll
                for (int m = 0; m < 4; ++m)
#pragma unroll
                    for (int n = 0; n < 2; ++n) acc[a][b][m][n] = (f32x4){0.f, 0.f, 0.f, 0.f};
        cur = nxt; cA = nA; cB = nB; ++ui;
        if constexpr (ALIGN_EPI) { if (wr == 1) PG8_BAR; }
    }
    PG8_WAIT_V(0);
    if constexpr (!ALIGN_EPI) { if (wr == 0) PG8_BAR; }
    PG8_BAR;
    if constexpr (Epi::AFTER_DRAIN) { E.fused(acc, cur, wr, wc, fr, fq, lds, wid, lane); S.done(cur); }
#undef PG8_SA
#undef PG8_SB
#undef PG8_STAGE
#undef PG8_LDA
#undef PG8_LDB
#undef PG8_MMA
#undef PG8_WAIT_V
#undef PG8_WAIT_L
#undef PG8_BAR
#undef PG8_SCHED
}
}
constexpr int NWAVES = 8;
constexpr int BATCH = 8, SEQ = 2048, DM = 1024, M = BATCH * SEQ, FFN = 2816, NMEM = 256, DEPTH = 4;
constexpr int MROWS = BATCH * NMEM;
constexpr int AB_IN = 2240, AB_INP = 2304, C_IN = 1224, C_INP = 1280;
constexpr float EPS = 1e-6f;
constexpr float LOG2E = 1.4426950408889634f;
constexpr int U_CQ = 0, U_CKV = 384, U_KR = 640, U_XM = 704, U_VM = 1216, U_OG = 1728;
constexpr int V_CQ = 0, V_CKV = 384, V_QI = 640, V_KI = 1152, V_WI = 1216;

constexpr size_t MiB = 1u << 20;
constexpr size_t WS_CTL = 0, CTL_BYTES = 1 * MiB;
constexpr size_t WS_WGU = 1 * MiB;
constexpr size_t WS_WDN = WS_WGU + 22 * MiB;
constexpr size_t WS_WXQ = WS_WDN + 11 * MiB;
constexpr size_t WS_WXKV = WS_WXQ + 1 * MiB;
constexpr size_t WS_WXO = WS_WXKV + 2 * MiB;
constexpr size_t WS_WIN = WS_WXO + 1 * MiB;
constexpr size_t WS_WOUT = WS_WIN + 5 * MiB;
constexpr size_t WS_WUQ = WS_WOUT + 2 * MiB;
constexpr size_t WS_WUKV = WS_WUQ + 1 * MiB;
constexpr size_t WS_WQK = WS_WUKV + 1 * MiB;
constexpr size_t WS_WGEFF = WS_WQK + 1 * MiB;
constexpr size_t WS_MEMN = WS_WGEFF + 1 * MiB;
constexpr size_t WS_KVX = WS_MEMN + 4 * MiB;
constexpr size_t WS_ROPE = WS_KVX + 4 * MiB;
constexpr size_t WS_XB = WS_ROPE + 4 * MiB;
constexpr size_t WS_Y = WS_XB + 32 * MiB;
constexpr size_t WS_BIG = WS_Y + 32 * MiB;
constexpr size_t WS_ACT = WS_BIG;
constexpr size_t WS_U = WS_BIG;
constexpr size_t WS_CQN = WS_U + 72 * MiB;
constexpr size_t WS_CKVN = WS_CQN + 12 * MiB;
constexpr size_t WS_KR = WS_CKVN + 8 * MiB;
constexpr size_t WS_XC = WS_KR + 2 * MiB;
constexpr size_t WS_GATE = WS_XC + 16 * MiB;
constexpr size_t WS_FG = WS_GATE + 1 * MiB;
constexpr size_t WS_QA = WS_FG + 1 * MiB;
constexpr size_t WS_KVA = WS_QA + 32 * MiB;
constexpr size_t WS_QKM = WS_KVA + 64 * MiB;
constexpr size_t WS_HM = WS_QKM + 32 * MiB;
constexpr size_t WS_MIX = WS_HM + 16 * MiB;
constexpr size_t WS_BM = WS_MIX + 32 * MiB;
constexpr size_t WS_QX = WS_U;
constexpr size_t WS_OX = WS_U + 16 * MiB;
constexpr size_t WS_END = WS_BM + 4 * MiB;
static_assert(WS_ACT + (size_t)M * FFN * 2 <= WS_END, "ACT fits the big region");
static_assert(WS_END <= 440 * MiB, "d_ws budget");
constexpr int CW_BAR = 4096;

constexpr int RING_BYTES = 131072;
constexpr int LDSCTL_OFF = RING_BYTES, MISC_OFF = LDSCTL_OFF + 320;
constexpr int LDS_BYTES = 147456;

#define GAS __attribute__((address_space(1)))
#define LAS __attribute__((address_space(3)))
typedef unsigned short bf16;
typedef unsigned v4u __attribute__((ext_vector_type(4)));
typedef unsigned v2u __attribute__((ext_vector_type(2)));
typedef float f32x4 __attribute__((ext_vector_type(4)));
#define LDS_WAIT() asm volatile("s_waitcnt lgkmcnt(0)" ::: "memory")
#define VM_WAIT() asm volatile("s_waitcnt vmcnt(0)" ::: "memory")
__device__ __forceinline__ unsigned f2bf(float f) { unsigned u = __builtin_bit_cast(unsigned, f); return (u + 0x7fffu + ((u >> 16) & 1u)) >> 16; }
__device__ __forceinline__ unsigned pk2(float lo, float hi) { return f2bf(lo) | (f2bf(hi) << 16); }
__device__ __forceinline__ float bflo(unsigned w) { return __uint_as_float(w << 16); }
__device__ __forceinline__ float bfhi(unsigned w) { return __uint_as_float(w & 0xffff0000u); }
__device__ __forceinline__ float bf2f(bf16 b) { return __uint_as_float((unsigned)b << 16); }
__device__ __forceinline__ void unpack8(const v4u w, float (&f)[8]) { f[0] = bflo(w.x); f[1] = bfhi(w.x); f[2] = bflo(w.y); f[3] = bfhi(w.y); f[4] = bflo(w.z); f[5] = bfhi(w.z); f[6] = bflo(w.w); f[7] = bfhi(w.w); }
__device__ __forceinline__ v4u pack8(const float (&f)[8]) { v4u w; w.x = pk2(f[0], f[1]); w.y = pk2(f[2], f[3]); w.z = pk2(f[4], f[5]); w.w = pk2(f[6], f[7]); return w; }
#define SWZ_XOR(v, x) __uint_as_float((unsigned)__builtin_amdgcn_ds_swizzle((int)__float_as_uint(v), 0x1f | ((x) << 10)))
__device__ __forceinline__ float wave_sum(float v) {
    v += SWZ_XOR(v, 1); v += SWZ_XOR(v, 2); v += SWZ_XOR(v, 4); v += SWZ_XOR(v, 8); v += SWZ_XOR(v, 16);
    const auto rr = __builtin_amdgcn_permlane32_swap(__float_as_uint(v), __float_as_uint(v), false, false);
    return __uint_as_float(rr[0]) + __uint_as_float(rr[1]);
}
__device__ __forceinline__ float wave_max(float v) {
    v = fmaxf(v, SWZ_XOR(v, 1)); v = fmaxf(v, SWZ_XOR(v, 2)); v = fmaxf(v, SWZ_XOR(v, 4)); v = fmaxf(v, SWZ_XOR(v, 8)); v = fmaxf(v, SWZ_XOR(v, 16));
    const auto rr = __builtin_amdgcn_permlane32_swap(__float_as_uint(v), __float_as_uint(v), false, false);
    return fmaxf(__uint_as_float(rr[0]), __uint_as_float(rr[1]));
}
__device__ __forceinline__ float rdlane(float v, int l) { return __uint_as_float((unsigned)__builtin_amdgcn_readlane((int)__float_as_uint(v), l)); }
#define XB_TMO      128
#define XB_XCNT(j)  (256  + 64 * (j))
#define XB_XSUB(j)  (1280 + 64 * (j))
#define XB_XGEN(j)  (2304 + 64 * (j))
#define XB_TOP      3328
#define XB_TOPGEN   3392
#define XCD_BAR_WORDS 3456
#define XB_SPIN_CAP (1u << 18)

__device__ __forceinline__ unsigned xb_ld(unsigned* p)              { return __hip_atomic_load(p, __ATOMIC_RELAXED, __HIP_MEMORY_SCOPE_AGENT); }
__device__ __forceinline__ unsigned xb_add(unsigned* p, unsigned v) { return __hip_atomic_fetch_add(p, v, __ATOMIC_RELAXED, __HIP_MEMORY_SCOPE_AGENT); }
__device__ __forceinline__ unsigned xb_xcc_id() { return (unsigned)__builtin_amdgcn_s_getreg((3 << 11) | 20) & 0xFu; }
#define XB_SPIN(cond, bar) do { unsigned _sp = 0; while (cond) { __builtin_amdgcn_s_sleep(1); \
    if ((++_sp & 255u) == 0u) { if (xb_ld(&(bar)[XB_TMO])) break; if (_sp > XB_SPIN_CAP) { atomicAdd(&(bar)[XB_TMO], 1u); break; } } } } while (0)

struct XcdBarrier {
    unsigned* bar; unsigned x;
    volatile LAS unsigned* st;
};

__device__ __forceinline__ XcdBarrier xcd_barrier_post(unsigned* bar, volatile LAS unsigned* st) {
    XcdBarrier b; b.bar = bar; b.x = xb_xcc_id(); b.st = st;
    if (threadIdx.x == 0) (void)xb_add(&bar[XB_XCNT(b.x)], 1u);
    return b;
}
__device__ __forceinline__ void xcd_barrier_complete(unsigned* bar, unsigned x, unsigned& nloc, unsigned& nx) {
    const unsigned G = gridDim.x * gridDim.y * gridDim.z;
    unsigned sum, cnt, mine, sp = 0u;
    for (;;) {
        sum = 0u; cnt = 0u; mine = 0u;
#pragma unroll
        for (unsigned j = 0; j < 16; ++j) { const unsigned c = xb_ld(&bar[XB_XCNT(j)]); sum += c; cnt += (c > 0u) ? 1u : 0u; mine = (j == x) ? c : mine; }
        if (sum == G) break;
        __builtin_amdgcn_s_sleep(1);
        if ((++sp & 255u) == 0u) { if (xb_ld(&bar[XB_TMO])) break; if (sp > XB_SPIN_CAP) { atomicAdd(&bar[XB_TMO], 1u); break; } }
    }
    nloc = mine > 0u ? mine : 1u; nx = cnt > 0u ? cnt : 1u;
}

__device__ __forceinline__ void xcd_barrier(const XcdBarrier& b) {
    asm volatile("s_waitcnt vmcnt(0)" ::: "memory");
    __syncthreads();
    if (threadIdx.x == 0) {
        unsigned* bar = b.bar; asm volatile("" : "+s"(bar));
        __builtin_amdgcn_s_waitcnt(0);
        unsigned nloc = b.st[0], nx = b.st[1];
        if (nloc == 0u) { xcd_barrier_complete(bar, b.x, nloc, nx); b.st[0] = nloc; b.st[1] = nx; }
        const unsigned old = xb_add(&bar[XB_XSUB(b.x)], 1u);
        const unsigned gen = old / nloc;
        if (old + 1u == (gen + 1u) * nloc) {
            __builtin_amdgcn_fence(__ATOMIC_RELEASE, "agent");
            asm volatile("s_waitcnt vmcnt(0)" ::: "memory");
            const unsigned og = xb_add(&bar[XB_TOP], 1u);
            const unsigned tg = og / nx;
            if (og + 1u == (tg + 1u) * nx) xb_add(&bar[XB_TOPGEN], 1u);
            else XB_SPIN(xb_ld(&bar[XB_TOPGEN]) == tg, bar);
            __builtin_amdgcn_fence(__ATOMIC_ACQUIRE, "agent");
            xb_add(&bar[XB_XGEN(b.x)], 1u);
            asm volatile("s_waitcnt vmcnt(0)" ::: "memory");
        } else {
            XB_SPIN(xb_ld(&bar[XB_XGEN(b.x)]) == gen, bar);
            __builtin_amdgcn_fence(__ATOMIC_ACQUIRE, "agent");
            asm volatile("s_waitcnt vmcnt(0)" ::: "memory");
        }
    }
    __syncthreads();
}
struct Params { const float* in[33]; float* out; unsigned char* ws; int st_lo, st_hi; };
struct Frame { LAS unsigned char* lds; int tid, lane, wave, G, gw, NGW; };
enum { I_X = 0, I_MEM, I_POS, I_NORMG, I_MEMG, I_WG, I_WU, I_WD, I_XQ, I_XK, I_XV, I_XO, I_ABIN, I_ABOUT, I_ACQG, I_ACKVG, I_AUQ, I_AUKV, I_CONVW, I_CONVB, I_MLWQ, I_MLWK,
       I_WGATES, I_BGATES, I_GNG, I_SKIP, I_CIN, I_COUT, I_CCQG, I_CCKVG, I_CUQ, I_CUK, I_CUV };

struct MapId { int off; __device__ __forceinline__ int operator()(int n) const { return off + n; } };
struct MapGU { int off; __device__ __forceinline__ int operator()(int n) const { return ((n >> 7) << 8) + (n & 127) + off; } };
struct MapRopeQ { __device__ __forceinline__ int operator()(int n) const { const int h = n / 192, w = n % 192; return w < 128 ? n : h * 192 + 128 + 2 * ((w - 128) & 31) + ((w - 128) >> 5); } };
template <class Map>
__device__ __forceinline__ void tr_item(const float* __restrict__ W, int ldw, int Nvalid, int k0, int n0, bf16* WT, int ldt, int dcol0, float scale, const Map& map, LAS float* scr, int lane) {
    const int nn = lane & 31; const bool ok = (n0 + nn) < Nvalid;
#pragma unroll 8
    for (int i = 0; i < 32; ++i) { const int kk = 2 * i + (lane >> 5); scr[kk * 33 + nn] = ok ? W[(size_t)(k0 + kk) * ldw + n0 + nn] * scale : 0.f; }
    LDS_WAIT(); asm volatile("" ::: "memory");
    const int c = lane & 7;
#pragma unroll
    for (int j = 0; j < 4; ++j) { const int n = (lane >> 3) + 8 * j; const LAS float* s = scr + (8 * c) * 33 + n;
        v4u o; o.x = pk2(s[0 * 33], s[1 * 33]); o.y = pk2(s[2 * 33], s[3 * 33]); o.z = pk2(s[4 * 33], s[5 * 33]); o.w = pk2(s[6 * 33], s[7 * 33]);
        *(v4u*)(WT + (size_t)map(n0 + n) * ldt + dcol0 + k0 + 8 * c) = o; }
    LDS_WAIT(); asm volatile("" ::: "memory");
}
template <class Map>
__device__ __forceinline__ void conv_mat(const Frame& F, int& cur, const float* W, int K, int N, int ldw, bf16* WT, int ldt, int dcol0, float scale, const Map& map) {
    LAS float* scr = (LAS float*)(F.lds + F.wave * 16384);
    const int nblk = (N + 31) / 32, nitems = (K / 64) * nblk;
    int first = F.gw - cur; if (first < 0) first += F.NGW;
    for (int it = first; it < nitems; it += F.NGW) { const int kb = it / nblk, nb = it % nblk; tr_item(W, ldw, N, 64 * kb, 32 * nb, WT, ldt, dcol0, scale, map, scr, F.lane); }
    cur = (cur + nitems) % F.NGW;
}
__device__ __forceinline__ void zero_bytes(const Frame& F, void* p, size_t nbytes) {
    const size_t n16 = nbytes / 16; unsigned zz = 0u; asm volatile("" : "+v"(zz)); const v4u z = {zz, zz, zz, zz};
    for (size_t i = (size_t)blockIdx.x * 512 + F.tid; i < n16; i += (size_t)F.G * 512) ((v4u*)p)[i] = z;
}

__device__ __forceinline__ void ld_row_f32(const float* p, int lane, float (&v)[16]) {
#pragma unroll
    for (int j = 0; j < 2; ++j) { const f32x4 a = *(const f32x4*)(p + 512 * j + 8 * lane), b = *(const f32x4*)(p + 512 * j + 8 * lane + 4);
        v[8 * j + 0] = a[0]; v[8 * j + 1] = a[1]; v[8 * j + 2] = a[2]; v[8 * j + 3] = a[3]; v[8 * j + 4] = b[0]; v[8 * j + 5] = b[1]; v[8 * j + 6] = b[2]; v[8 * j + 7] = b[3]; }
}
__device__ __forceinline__ void st_row_f32(float* p, int lane, const float (&v)[16]) {
#pragma unroll
    for (int j = 0; j < 2; ++j) { *(f32x4*)(p + 512 * j + 8 * lane) = (f32x4){v[8 * j + 0], v[8 * j + 1], v[8 * j + 2], v[8 * j + 3]}; *(f32x4*)(p + 512 * j + 8 * lane + 4) = (f32x4){v[8 * j + 4], v[8 * j + 5], v[8 * j + 6], v[8 * j + 7]}; }
}
__device__ __forceinline__ void ld_row_bf16(const bf16* p, int lane, float (&v)[16]) {
#pragma unroll
    for (int j = 0; j < 2; ++j) { const v4u w = *(const v4u*)(p + 512 * j + 8 * lane); float f[8]; unpack8(w, f);
#pragma unroll
        for (int e = 0; e < 8; ++e) v[8 * j + e] = f[e]; }
}
__device__ __forceinline__ void st_row_bf16(bf16* p, int lane, const float (&v)[16]) {
#pragma unroll
    for (int j = 0; j < 2; ++j) { v4u w; w.x = pk2(v[8 * j + 0], v[8 * j + 1]); w.y = pk2(v[8 * j + 2], v[8 * j + 3]); w.z = pk2(v[8 * j + 4], v[8 * j + 5]); w.w = pk2(v[8 * j + 6], v[8 * j + 7]); *(v4u*)(p + 512 * j + 8 * lane) = w; }
}
__device__ __forceinline__ float ssq16(const float (&v)[16]) { float s = 0.f;
#pragma unroll
    for (int e = 0; e < 16; ++e) s += v[e] * v[e];
    return wave_sum(s); }
__device__ __forceinline__ void t_norm(const Frame& F, const float* xin, float* xout, const bf16* Y, float cmul, const float* gpost, const float* gpre, bf16* XB) {
    for (int m = F.gw; m < M; m += F.NGW) {
        float x[16]; ld_row_f32(xin + (size_t)m * DM, F.lane, x);
        if (Y) { float y[16], g[16]; ld_row_bf16(Y + (size_t)m * DM, F.lane, y); ld_row_f32(gpost, F.lane, g);
            const float rs = cmul * __builtin_amdgcn_rsqf(ssq16(y) * (1.0f / DM) + EPS);
#pragma unroll
            for (int e = 0; e < 16; ++e) x[e] += y[e] * rs * g[e]; }
        st_row_f32(xout + (size_t)m * DM, F.lane, x);
        if (gpre) { float g[16]; ld_row_f32(gpre, F.lane, g); const float rs = __builtin_amdgcn_rsqf(ssq16(x) * (1.0f / DM) + EPS);
#pragma unroll
            for (int e = 0; e < 16; ++e) x[e] = x[e] * rs * g[e];
            st_row_bf16(XB + (size_t)m * DM, F.lane, x); }
    }
}
__device__ __forceinline__ void t_memn(const Frame& F, const float* mem, const float* g, bf16* MEMN) {
    for (int m = F.gw; m < MROWS; m += F.NGW) { float x[16], gg[16]; ld_row_f32(mem + (size_t)m * DM, F.lane, x); ld_row_f32(g, F.lane, gg);
        const float rs = __builtin_amdgcn_rsqf(ssq16(x) * (1.0f / DM) + EPS);
#pragma unroll
        for (int e = 0; e < 16; ++e) x[e] = x[e] * rs * gg[e];
        st_row_bf16(MEMN + (size_t)m * DM, F.lane, x); }
}
__device__ __forceinline__ void t_rope_table(const Frame& F, const int* pos, float* ROPE) {
    for (int idx = blockIdx.x * 512 + F.tid; idx < M * 32; idx += F.G * 512) { const int m = idx >> 5, i = idx & 31;
        const float inv = __builtin_amdgcn_exp2f(-(float)i * (13.287712379549449f / 32.0f));
        const double rev = (double)pos[m] * (double)inv * 0.15915494309189535;
        const float fr = (float)(rev - __builtin_floor(rev));
        ROPE[2 * idx] = __builtin_amdgcn_cosf(fr); ROPE[2 * idx + 1] = __builtin_amdgcn_sinf(fr); }
}
__device__ __forceinline__ void t_weff(const Frame& F, const float* wq, const float* wk, const float* wg, float* WGEFF) {
    for (int idx = blockIdx.x * 512 + F.tid; idx < 1024 * 8; idx += F.G * 512) { const int k = idx >> 3, g = idx & 7; float s;
        if (k < 512) { const int h = k >> 7, d = k & 127; const float* q = wq + ((size_t)h * 128 + d) * 128; const float* kk = wk + ((size_t)h * 128 + d) * 128; s = 0.f;
            for (int e = 0; e < 128; ++e) s += q[e] * wg[(size_t)(h * 128 + e) * 8 + g] + kk[e] * wg[(size_t)(512 + h * 128 + e) * 8 + g]; }
        else s = wg[(size_t)(1024 + (k - 512)) * 8 + g];
        WGEFF[idx] = s; }
}
__device__ __forceinline__ float log_sigmoid(float x) {
    const float y = __expf(-fabsf(x));
    const float l1p = (y < 0.02f) ? y * (1.0f - y * (0.5f - y * (0.33333333f - 0.25f * y))) : __logf(1.0f + y);
    return fminf(x, 0.f) - l1p;
}
__device__ __forceinline__ void t_prep_even(const Frame& F, const bf16* U, const float* cqg, const float* ckvg, const float* ROPE, const float* convw, const float* convb,
                                            const float* WGEFF, const float* bgates, bf16* CQN, bf16* CKVN, bf16* KR, bf16* XC, float* GATE) {
    const int lane = F.lane;
    for (int m = F.gw; m < M; m += F.NGW) { const bf16* u = U + (size_t)m * AB_INP; const int t = m & (SEQ - 1);
        { float v[8]; float s = 0.f; if (lane < 48) { unpack8(*(const v4u*)(u + U_CQ + 8 * lane), v);
#pragma unroll
                for (int e = 0; e < 8; ++e) s += v[e] * v[e]; }
          const float rs = __builtin_amdgcn_rsqf(wave_sum(s) * (1.0f / 384.0f) + EPS);
          if (lane < 48) { const f32x4 g0 = *(const f32x4*)(cqg + 8 * lane), g1 = *(const f32x4*)(cqg + 8 * lane + 4);
              float o[8] = {v[0] * rs * g0[0], v[1] * rs * g0[1], v[2] * rs * g0[2], v[3] * rs * g0[3], v[4] * rs * g1[0], v[5] * rs * g1[1], v[6] * rs * g1[2], v[7] * rs * g1[3]};
              *(v4u*)(CQN + (size_t)m * 384 + 8 * lane) = pack8(o); } }
        { float v[8]; float s = 0.f; if (lane < 32) { unpack8(*(const v4u*)(u + U_CKV + 8 * lane), v);
#pragma unroll
                for (int e = 0; e < 8; ++e) s += v[e] * v[e]; }
          const float rs = __builtin_amdgcn_rsqf(wave_sum(s) * (1.0f / 256.0f) + EPS);
          if (lane < 32) { const f32x4 g0 = *(const f32x4*)(ckvg + 8 * lane), g1 = *(const f32x4*)(ckvg + 8 * lane + 4);
              float o[8] = {v[0] * rs * g0[0], v[1] * rs * g0[1], v[2] * rs * g0[2], v[3] * rs * g0[3], v[4] * rs * g1[0], v[5] * rs * g1[1], v[6] * rs * g1[2], v[7] * rs * g1[3]};
              *(v4u*)(CKVN + (size_t)m * 256 + 8 * lane) = pack8(o); } }
        if (lane < 32) { const float x1 = bf2f(u[U_KR + lane]), x2 = bf2f(u[U_KR + 32 + lane]); const float c = ROPE[((size_t)m * 32 + lane) * 2], sn = ROPE[((size_t)m * 32 + lane) * 2 + 1];
            *(unsigned*)(KR + (size_t)m * 64 + 2 * lane) = pk2(x1 * c - x2 * sn, x1 * sn + x2 * c); }
        float xc[8];
        { const f32x4 b0 = *(const f32x4*)(convb + 8 * lane), b1 = *(const f32x4*)(convb + 8 * lane + 4);
          float a[8] = {b0[0], b0[1], b0[2], b0[3], b1[0], b1[1], b1[2], b1[3]};
#pragma unroll
          for (int j = 0; j < 4; ++j) { if (t - 3 + j >= 0) { float v[8]; unpack8(*(const v4u*)(u + (ptrdiff_t)(j - 3) * AB_INP + U_XM + 8 * lane), v);
                  const f32x4 w0 = *(const f32x4*)(convw + j * 512 + 8 * lane), w1 = *(const f32x4*)(convw + j * 512 + 8 * lane + 4);
                  a[0] += v[0] * w0[0]; a[1] += v[1] * w0[1]; a[2] += v[2] * w0[2]; a[3] += v[3] * w0[3]; a[4] += v[4] * w1[0]; a[5] += v[5] * w1[1]; a[6] += v[6] * w1[2]; a[7] += v[7] * w1[3]; } }
#pragma unroll
          for (int e = 0; e < 8; ++e) xc[e] = a[e] * __builtin_amdgcn_rcpf(1.0f + __expf(-a[e]));
          *(v4u*)(XC + (size_t)m * 512 + 8 * lane) = pack8(xc); }
        { float vm[8]; unpack8(*(const v4u*)(u + U_VM + 8 * lane), vm); float gs[8];
#pragma unroll
          for (int g = 0; g < 8; ++g) gs[g] = 0.f;
#pragma unroll
          for (int e = 0; e < 8; ++e) { const f32x4 a0 = *(const f32x4*)(WGEFF + (size_t)(8 * lane + e) * 8), a1 = *(const f32x4*)(WGEFF + (size_t)(8 * lane + e) * 8 + 4);
              const f32x4 c0 = *(const f32x4*)(WGEFF + (size_t)(512 + 8 * lane + e) * 8), c1 = *(const f32x4*)(WGEFF + (size_t)(512 + 8 * lane + e) * 8 + 4);
              gs[0] += xc[e] * a0[0] + vm[e] * c0[0]; gs[1] += xc[e] * a0[1] + vm[e] * c0[1]; gs[2] += xc[e] * a0[2] + vm[e] * c0[2]; gs[3] += xc[e] * a0[3] + vm[e] * c0[3];
              gs[4] += xc[e] * a1[0] + vm[e] * c1[0]; gs[5] += xc[e] * a1[1] + vm[e] * c1[1]; gs[6] += xc[e] * a1[2] + vm[e] * c1[2]; gs[7] += xc[e] * a1[3] + vm[e] * c1[3]; }
#pragma unroll
          for (int g = 0; g < 8; ++g) gs[g] = wave_sum(gs[g]) + bgates[g];
          if (lane == 0) { *(f32x4*)(GATE + (size_t)m * 8) = (f32x4){gs[0], gs[1], gs[2], gs[3]};
              *(f32x4*)(GATE + (size_t)m * 8 + 4) = (f32x4){log_sigmoid(gs[4]), log_sigmoid(gs[5]), log_sigmoid(gs[6]), log_sigmoid(gs[7])}; } }
    }
}
__device__ __forceinline__ void t_scan(const Frame& F, const float* GATE, float* FG, int seq) {
    const int b = seq >> 2, h = seq & 3, lane = F.lane; const size_t m0 = (size_t)b * SEQ + 32 * lane;
    float lf[32]; float run = 0.f;
#pragma unroll
    for (int i = 0; i < 32; ++i) { run += GATE[(m0 + i) * 8 + 4 + h]; lf[i] = run; }
    float pre = run;
#pragma unroll
    for (int o = 1; o < 64; o <<= 1) { const float t = __uint_as_float((unsigned)__builtin_amdgcn_ds_bpermute((lane - o) * 4, (int)__float_as_uint(pre))); if (lane >= o) pre += t; }
    const float base = pre - run;
#pragma unroll
    for (int i = 0; i < 32; ++i) { const float Fv = base + lf[i]; const float li = GATE[(m0 + i) * 8 + h];
        FG[((m0 + i) * 4 + h) * 2] = Fv * LOG2E; FG[((m0 + i) * 4 + h) * 2 + 1] = (li - Fv) * LOG2E; }
}
__device__ __forceinline__ void t_mix(const Frame& F, const bf16* HM, const bf16* XC, const bf16* U, const float* gng, const float* skip, bf16* MIX) {
    const int lane = F.lane;
    for (int m = F.gw; m < M; m += F.NGW) { float h[8], xc[8], og[8];
        unpack8(*(const v4u*)(HM + (size_t)m * 512 + 8 * lane), h); unpack8(*(const v4u*)(XC + (size_t)m * 512 + 8 * lane), xc); unpack8(*(const v4u*)(U + (size_t)m * AB_INP + U_OG + 8 * lane), og);
        float s = 0.f;
#pragma unroll
        for (int e = 0; e < 8; ++e) s += h[e];
        s += SWZ_XOR(s, 1); s += SWZ_XOR(s, 2); s += SWZ_XOR(s, 4); s += SWZ_XOR(s, 8);
        const float mu = s * (1.0f / 128.0f); float q = 0.f;
#pragma unroll
        for (int e = 0; e < 8; ++e) { h[e] -= mu; q += h[e] * h[e]; }
        q += SWZ_XOR(q, 1); q += SWZ_XOR(q, 2); q += SWZ_XOR(q, 4); q += SWZ_XOR(q, 8);
        const float rs = __builtin_amdgcn_rsqf(q * (1.0f / 128.0f) + EPS);
        const f32x4 g0 = *(const f32x4*)(gng + 8 * lane), g1 = *(const f32x4*)(gng + 8 * lane + 4), k0 = *(const f32x4*)(skip + 8 * lane), k1 = *(const f32x4*)(skip + 8 * lane + 4);
        const float gg[8] = {g0[0], g0[1], g0[2], g0[3], g1[0], g1[1], g1[2], g1[3]}, kk[8] = {k0[0], k0[1], k0[2], k0[3], k1[0], k1[1], k1[2], k1[3]}; float o[8];
#pragma unroll
        for (int e = 0; e < 8; ++e) o[e] = (h[e] * rs * gg[e] + kk[e] * xc[e]) * __builtin_amdgcn_rcpf(1.0f + __expf(-og[e]));
        *(v4u*)(MIX + (size_t)m * DM + 512 + 8 * lane) = pack8(o); }
}
__device__ __forceinline__ void t_prep_odd(const Frame& F, const bf16* U, const float* cqg, const float* ckvg, bf16* CQN, bf16* CKVN) {
    const int lane = F.lane;
    for (int m = F.gw; m < M; m += F.NGW) { const bf16* u = U + (size_t)m * C_INP;
        { float v[8]; float s = 0.f; if (lane < 48) { unpack8(*(const v4u*)(u + V_CQ + 8 * lane), v);
#pragma unroll
                for (int e = 0; e < 8; ++e) s += v[e] * v[e]; }
          const float rs = __builtin_amdgcn_rsqf(wave_sum(s) * (1.0f / 384.0f) + EPS);
          if (lane < 48) { const f32x4 g0 = *(const f32x4*)(cqg + 8 * lane), g1 = *(const f32x4*)(cqg + 8 * lane + 4);
              float o[8] = {v[0] * rs * g0[0], v[1] * rs * g0[1], v[2] * rs * g0[2], v[3] * rs * g0[3], v[4] * rs * g1[0], v[5] * rs * g1[1], v[6] * rs * g1[2], v[7] * rs * g1[3]};
              *(v4u*)(CQN + (size_t)m * 384 + 8 * lane) = pack8(o); } }
        { float v[8]; float s = 0.f; if (lane < 32) { unpack8(*(const v4u*)(u + V_CKV + 8 * lane), v);
#pragma unroll
                for (int e = 0; e < 8; ++e) s += v[e] * v[e]; }
          const float rs = __builtin_amdgcn_rsqf(wave_sum(s) * (1.0f / 256.0f) + EPS);
          if (lane < 32) { const f32x4 g0 = *(const f32x4*)(ckvg + 8 * lane), g1 = *(const f32x4*)(ckvg + 8 * lane + 4);
              float o[8] = {v[0] * rs * g0[0], v[1] * rs * g0[1], v[2] * rs * g0[2], v[3] * rs * g0[3], v[4] * rs * g1[0], v[5] * rs * g1[1], v[6] * rs * g1[2], v[7] * rs * g1[3]};
              *(v4u*)(CKVN + (size_t)m * 256 + 8 * lane) = pack8(o); } }
    }
}
__device__ __forceinline__ unsigned fkey(float f) { const unsigned u = __float_as_uint(f); return (u & 0x80000000u) ? ~u : (u | 0x80000000u); }
__device__ __forceinline__ void topk_bitmap(const LAS float* row, int t, unsigned* bmrow, int lane) {
    unsigned u[32];
#pragma unroll
    for (int i = 0; i < 32; ++i) u[i] = (lane <= t - 64 * i) ? fkey(row[lane + 64 * i]) : 0u;
    unsigned tau = 0u;
#pragma unroll 1
    for (int bit = 31; bit >= 0; --bit) { const unsigned cand = tau | (1u << bit); int cnt = 0;
#pragma unroll
        for (int i = 0; i < 32; ++i) cnt += __popcll(__ballot(u[i] >= cand));
        if (cnt >= 256) tau = cand; }
    int cgt = 0;
#pragma unroll
    for (int i = 0; i < 32; ++i) cgt += __popcll(__ballot(u[i] > tau));
    int rem = 256 - cgt; unsigned myword = 0u;
#pragma unroll
    for (int i = 0; i < 32; ++i) { const unsigned long long gt = __ballot(u[i] > tau), eq = __ballot(u[i] == tau); const int pc = __popcll(eq); unsigned long long sel;
        if (pc <= rem) { sel = eq; rem -= pc; }
        else { const int rank = __popcll(eq & ((1ull << lane) - 1ull)); sel = __ballot(u[i] == tau && rank < rem); rem = 0; }
        const unsigned long long w = gt | sel;
        { const unsigned wlo = (unsigned)__builtin_amdgcn_readfirstlane((int)(unsigned)w), whi = (unsigned)__builtin_amdgcn_readfirstlane((int)(unsigned)(w >> 32));
          asm volatile("v_writelane_b32 %0, %1, %2" : "+v"(myword) : "s"(wlo), "i"(2 * i));
          asm volatile("v_writelane_b32 %0, %1, %2" : "+v"(myword) : "s"(whi), "i"(2 * i + 1)); } }
    bmrow[lane] = myword;
}
__device__ __forceinline__ void ph_indexer_simple(const Frame& F, const bf16* U, unsigned* BM) {
    const int lane = F.lane; LAS float* qs = (LAS float*)(F.lds + F.wave * 12288); LAS float* sc = qs + 512;
    for (int m = F.gw; m < M; m += F.NGW) { const int t = m & (SEQ - 1), kb = m - t; unsigned* bmrow = BM + (size_t)m * 64;
        if (t < 256) { const int n = t + 1 - 32 * lane; bmrow[lane] = n >= 32 ? 0xffffffffu : (n > 0 ? ((1u << n) - 1u) : 0u); continue; }
        const bf16* u = U + (size_t)m * C_INP;
        { float v[8]; unpack8(*(const v4u*)(u + V_QI + 8 * lane), v);
#pragma unroll
          for (int e = 0; e < 8; ++e) qs[8 * lane + e] = v[e]; }
        float wi[8]; { float v[8]; unpack8(*(const v4u*)(u + V_WI), v);
#pragma unroll
          for (int e = 0; e < 8; ++e) wi[e] = v[e]; }
        LDS_WAIT(); asm volatile("" ::: "memory");
        for (int j0 = 0; j0 <= t; j0 += 64) { const int j = j0 + lane; const bool valid = j <= t;
            const bf16* kr = U + (size_t)(kb + (valid ? j : t)) * C_INP + V_KI;
            float d[8];
#pragma unroll
            for (int h = 0; h < 8; ++h) d[h] = 0.f;
#pragma unroll 1
            for (int c = 0; c < 8; ++c) { asm volatile("" ::: "memory"); float v[8]; unpack8(*(const v4u*)(kr + 8 * c), v);
#pragma unroll
                for (int h = 0; h < 8; ++h) { const f32x4 q0 = *(const LAS f32x4*)(qs + h * 64 + 8 * c), q1 = *(const LAS f32x4*)(qs + h * 64 + 8 * c + 4);
                    d[h] += q0[0] * v[0] + q0[1] * v[1] + q0[2] * v[2] + q0[3] * v[3] + q1[0] * v[4] + q1[1] * v[5] + q1[2] * v[6] + q1[3] * v[7]; } }
            float acc = 0.f;
#pragma unroll
            for (int h = 0; h < 8; ++h) acc += fmaxf(d[h], 0.f) * wi[h];
            sc[j] = valid ? acc : -__builtin_inff(); }
        LDS_WAIT(); asm volatile("" ::: "memory");
        topk_bitmap(sc, t, bmrow, lane);
        LDS_WAIT(); asm volatile("" ::: "memory");
    }
}

struct AttnBufs { const bf16 *qa_, *kva_, *kr_, *qkm_, *u_, *qd_, *kvd_, *qx_, *kvx_; const float* fg_; const unsigned* bm_; bf16 *mix_, *hm_, *ox_; };
template <int MODE>
__device__ __forceinline__ void attn_task(const AttnBufs& A, int m, int h, LAS float* qs, int lane) {
    constexpr int DK = (MODE == 0) ? 192 : 128;
    const int b = m >> 11, t = m & (SEQ - 1), kb = m - t;
    const bf16* qrow = MODE == 0 ? A.qa_ + (size_t)m * 768 + h * 192 : MODE == 1 ? A.qkm_ + (size_t)m * 1024 + h * 128 : MODE == 2 ? A.qd_ + (size_t)m * 1024 + h * 128 : A.qx_ + (size_t)m * 512 + h * 128;
    for (int d = lane; d < DK; d += 64) qs[d] = bf2f(qrow[d]);
    LDS_WAIT(); asm volatile("" ::: "memory");
    const int nkeys = MODE == 3 ? NMEM : t + 1;
    float mrun = -1e30f, l = 0.f, a0 = 0.f, a1 = 0.f;
    for (int j0 = 0; j0 < nkeys; j0 += 64) { asm volatile("" ::: "memory"); const int j = j0 + lane; bool valid = j < nkeys;
        if (MODE == 2) { const unsigned w = A.bm_[(size_t)m * 64 + (j0 >> 5) + (lane >> 5)]; valid = valid && ((w >> (lane & 31)) & 1u); }
        if (!__any(valid)) continue;
        float dot = 0.f, bias = 0.f;
        if (valid) {
            const size_t kr = MODE == 3 ? (size_t)(b * NMEM + j) : (size_t)(kb + j);
            const bf16* kp = MODE == 0 ? A.kva_ + kr * 1024 + h * 256 : MODE == 1 ? A.qkm_ + kr * 1024 + 512 + h * 128 : MODE == 2 ? A.kvd_ + kr * 2048 + h * 128 : A.kvx_ + kr * 1024 + h * 128;
#pragma unroll
            for (int c = 0; c < 16; ++c) { float v[8]; unpack8(*(const v4u*)(kp + 8 * c), v); const f32x4 q0 = *(const LAS f32x4*)(qs + 8 * c), q1 = *(const LAS f32x4*)(qs + 8 * c + 4);
                dot += q0[0] * v[0] + q0[1] * v[1] + q0[2] * v[2] + q0[3] * v[3] + q1[0] * v[4] + q1[1] * v[5] + q1[2] * v[6] + q1[3] * v[7]; }
            if (MODE == 0) { const bf16* kp2 = A.kr_ + kr * 64;
#pragma unroll
                for (int c = 0; c < 8; ++c) { float v[8]; unpack8(*(const v4u*)(kp2 + 8 * c), v); const f32x4 q0 = *(const LAS f32x4*)(qs + 128 + 8 * c), q1 = *(const LAS f32x4*)(qs + 128 + 8 * c + 4);
                    dot += q0[0] * v[0] + q0[1] * v[1] + q0[2] * v[2] + q0[3] * v[3] + q1[0] * v[4] + q1[1] * v[5] + q1[2] * v[6] + q1[3] * v[7]; } }
            if (MODE == 1) bias = A.fg_[(kr * 4 + h) * 2 + 1];
        }
        const float x = MODE == 1 ? bias : dot;
        const float cm = wave_max(valid ? x : -__builtin_inff());
        const float mn = fmaxf(mrun, cm), alpha = __builtin_amdgcn_exp2f(mrun - mn); mrun = mn;
        float p = valid ? __builtin_amdgcn_exp2f(x - mn) : 0.f; if (MODE == 1) p *= dot;
        l = l * alpha + wave_sum(p); a0 *= alpha; a1 *= alpha;
        const int cnt = (nkeys - j0) < 64 ? (nkeys - j0) : 64;
        const size_t vr0 = MODE == 3 ? (size_t)(b * NMEM + j0) : (size_t)(kb + j0);
        const bf16* vbase = MODE == 0 ? A.kva_ + vr0 * 1024 + h * 256 + 128 : MODE == 1 ? A.u_ + vr0 * AB_INP + U_VM + h * 128 : MODE == 2 ? A.kvd_ + vr0 * 2048 + 1024 + h * 128 : A.kvx_ + vr0 * 1024 + 512 + h * 128;
        constexpr int VLD = MODE == 0 ? 1024 : MODE == 1 ? AB_INP : MODE == 2 ? 2048 : 1024;
        for (int jj = 0; jj < cnt; ++jj) { const float pj = rdlane(p, jj);
            if (pj != 0.f) { const unsigned vv = *(const unsigned*)(vbase + (size_t)jj * VLD + 2 * lane); a0 += pj * bflo(vv); a1 += pj * bfhi(vv); } }
    }
    float inv;
    if (MODE == 1) { const float F2 = A.fg_[((size_t)m * 4 + h) * 2]; inv = 1.0f / fmaxf(fabsf(l), __builtin_amdgcn_exp2f(-(F2 + mrun))); }
    else inv = 1.0f / l;
    bf16* op = MODE == 0 ? A.mix_ + (size_t)m * 1024 + h * 128 : MODE == 1 ? A.hm_ + (size_t)m * 512 + h * 128 : MODE == 2 ? A.mix_ + (size_t)m * 1024 + h * 128 : A.ox_ + (size_t)m * 512 + h * 128;
    *(unsigned*)(op + 2 * lane) = pk2(a0 * inv, a1 * inv);
    LDS_WAIT(); asm volatile("" ::: "memory");
}
template <int MODE, int NH>
__device__ __forceinline__ void ph_attn_simple(const Frame& F, const AttnBufs& A) {
    LAS float* qs = (LAS float*)(F.lds + F.wave * 1024);
    for (int task = F.gw; task < M * NH; task += F.NGW) attn_task<MODE>(A, task / NH, task % NH, qs, F.lane);
}
template <class Epi>
__device__ __forceinline__ void run_gemm(const Frame& F, const bf16* A, const bf16* Bt, int Mr, int N, int K, const Epi& E, int crot) {
    pg8::Gemm g{A, Bt, Mr, N, K}; pg8::StaticOrder S; int c = (int)blockIdx.x - crot; if (c < 0) c += F.G; S.init(Mr, N, F.G, c);
    pg8::gemm_phase<Epi, pg8::StaticOrder, true, true>(F.lds, g, S, E, F.wave);
}

typedef const float* cfptr;
__device__ __forceinline__ cfptr inp_ptr(int i) {
    unsigned long long ka = (unsigned long long)__builtin_amdgcn_kernarg_segment_ptr(); asm volatile("" : "+s"(ka));
    const unsigned long long v = ((const __attribute__((address_space(4))) unsigned long long*)ka)[i];
    return (cfptr)(const __attribute__((address_space(1))) float*)v;
}
#define INP(i) inp_ptr(i)
__global__ void __launch_bounds__(NWAVES * 64, 2) mega_fwd(Params P) {
    extern __shared__ __attribute__((aligned(16))) unsigned char lds_raw[];
    const int wave_s = __builtin_amdgcn_readfirstlane((int)threadIdx.x >> 6);
#define MK_FRAME() Frame F; unsigned char* ws = P.ws; asm volatile("" : "+s"(ws)); { int l_o; asm volatile("v_mbcnt_lo_u32_b32 %0, -1, 0\n\tv_mbcnt_hi_u32_b32 %0, -1, %0" : "=v"(l_o)); F.lds = (LAS unsigned char*)lds_raw; F.lane = l_o; F.wave = wave_s; F.tid = wave_s * 64 + l_o; \
    F.G = gridDim.x; F.gw = blockIdx.x * NWAVES + F.wave; F.NGW = F.G * NWAVES; }
    MK_FRAME();
    for (int u = F.tid; u < (LDS_BYTES - LDSCTL_OFF) / 4; u += NWAVES * 64) ((LAS unsigned*)(F.lds + LDSCTL_OFF))[u] = 0u;
    __syncthreads();
    XcdBarrier bar = xcd_barrier_post((unsigned*)(ws + WS_CTL) + CW_BAR, (volatile LAS unsigned*)(F.lds + MISC_OFF) + 8);
    const int lo = P.st_lo, hi = P.st_hi; int step = 0;
#define STEP_BEGIN if (step >= lo && step < hi) { MK_FRAME();
#define STEP_END if (step + 1 < hi) xcd_barrier(bar); } ++step;

#define WGU ((bf16*)(ws + WS_WGU))
#define WDN ((bf16*)(ws + WS_WDN))
#define WXQ ((bf16*)(ws + WS_WXQ))
#define WXKV ((bf16*)(ws + WS_WXKV))
#define WXO ((bf16*)(ws + WS_WXO))
#define WIN ((bf16*)(ws + WS_WIN))
#define WOUT ((bf16*)(ws + WS_WOUT))
#define WUQ ((bf16*)(ws + WS_WUQ))
#define WUKV ((bf16*)(ws + WS_WUKV))
#define WQK ((bf16*)(ws + WS_WQK))
#define WGEFF ((float*)(ws + WS_WGEFF))
#define MEMN ((bf16*)(ws + WS_MEMN))
#define KVX ((bf16*)(ws + WS_KVX))
#define ROPE ((float*)(ws + WS_ROPE))
#define XB ((bf16*)(ws + WS_XB))
#define Y ((bf16*)(ws + WS_Y))
#define ACT ((bf16*)(ws + WS_ACT))
#define U ((bf16*)(ws + WS_U))
#define CQN ((bf16*)(ws + WS_CQN))
#define CKVN ((bf16*)(ws + WS_CKVN))
#define KR ((bf16*)(ws + WS_KR))
#define XC ((bf16*)(ws + WS_XC))
#define GATE ((float*)(ws + WS_GATE))
#define FG ((float*)(ws + WS_FG))
#define QA ((bf16*)(ws + WS_QA))
#define KVA ((bf16*)(ws + WS_KVA))
#define QKM ((bf16*)(ws + WS_QKM))
#define HM ((bf16*)(ws + WS_HM))
#define MIX ((bf16*)(ws + WS_MIX))
#define BM ((unsigned*)(ws + WS_BM))
#define QX ((bf16*)(ws + WS_QX))
#define OX ((bf16*)(ws + WS_OX))
#define X (P.out)
#define MK_AB() AttnBufs AB; AB.qa_ = QA; AB.kva_ = KVA; AB.kr_ = KR; AB.qkm_ = QKM; AB.u_ = U; AB.qd_ = QA; AB.kvd_ = KVA; AB.qx_ = QX; AB.kvx_ = KVX; AB.fg_ = FG; AB.bm_ = BM; AB.mix_ = MIX; AB.hm_ = HM; AB.ox_ = OX;
    STEP_BEGIN
        t_norm(F, INP(I_X), X, nullptr, 0.f, nullptr, INP(I_NORMG), XB);
        t_rope_table(F, (const int*)INP(I_POS), ROPE);
    STEP_END

    for (int it = 0; it < 2 * DEPTH; ++it) {
        const int l = it >> 1, f = it & 1, par = l & 1, e = l >> 1;
        const float* ng = INP(I_NORMG) + (size_t)l * 8 * DM;
        if (f == 0) {
            STEP_BEGIN
                int cur = 0;
                for (int ff = 0; ff < 2; ++ff) { const size_t wo = ((size_t)l * 2 + ff) * DM * FFN;
                    conv_mat(F, cur, INP(I_WG) + wo, DM, FFN, FFN, WGU + (size_t)ff * 5632 * DM, DM, 0, 1.f, MapGU{0});
                    conv_mat(F, cur, INP(I_WU) + wo, DM, FFN, FFN, WGU + (size_t)ff * 5632 * DM, DM, 0, 1.f, MapGU{128});
                    conv_mat(F, cur, INP(I_WD) + wo, FFN, DM, DM, WDN + (size_t)ff * DM * FFN, FFN, 0, 1.f, MapId{0}); }
                conv_mat(F, cur, INP(I_XQ) + (size_t)l * DM * 512, DM, 512, 512, WXQ, DM, 0, 1.f, MapId{0});
                conv_mat(F, cur, INP(I_XK) + (size_t)l * DM * 512, DM, 512, 512, WXKV, DM, 0, 1.f, MapId{0});
                conv_mat(F, cur, INP(I_XV) + (size_t)l * DM * 512, DM, 512, 512, WXKV, DM, 0, 1.f, MapId{512});
                conv_mat(F, cur, INP(I_XO) + (size_t)l * 512 * DM, 512, DM, DM, WXO, 512, 0, 1.f, MapId{0});
                t_memn(F, INP(I_MEM), INP(I_MEMG) + (size_t)l * DM, MEMN);
                if (par == 0) {
                    conv_mat(F, cur, INP(I_ABIN) + (size_t)e * DM * AB_IN, DM, AB_IN, AB_IN, WIN, DM, 0, 1.f, MapId{0});
                    zero_bytes(F, WIN + (size_t)AB_IN * DM, (size_t)(AB_INP - AB_IN) * DM * 2);
                    conv_mat(F, cur, INP(I_ABOUT) + (size_t)e * DM * DM, DM, DM, DM, WOUT, DM, 0, 1.f, MapId{0});
                    conv_mat(F, cur, INP(I_AUQ) + (size_t)e * 384 * 768, 384, 768, 768, WUQ, 384, 0, 1.f, MapRopeQ{});
                    conv_mat(F, cur, INP(I_AUKV) + (size_t)e * 256 * 1024, 256, 1024, 1024, WUKV, 256, 0, 1.f, MapId{0});
                    for (int h = 0; h < 4; ++h) {
                        conv_mat(F, cur, INP(I_MLWQ) + ((size_t)e * 4 + h) * 128 * 128, 128, 128, 128, WQK, 512, h * 128, 1.f, MapId{h * 128});
                        conv_mat(F, cur, INP(I_MLWK) + ((size_t)e * 4 + h) * 128 * 128, 128, 128, 128, WQK, 512, h * 128, 0.08838834764831845f, MapId{512 + h * 128}); }
                    for (int idx = blockIdx.x * 512 + F.tid; idx < 1024 * 48; idx += F.G * 512) { const int row = idx / 48, ch = idx % 48, hh = (row & 511) >> 7; int col = ch * 8; if (col >= hh * 128) col += 128;
                        unsigned zz = 0u; asm volatile("" : "+v"(zz)); *(v4u*)(WQK + (size_t)row * 512 + col) = (v4u){zz, zz, zz, zz}; }
                    t_weff(F, INP(I_MLWQ) + (size_t)e * 4 * 128 * 128, INP(I_MLWK) + (size_t)e * 4 * 128 * 128, INP(I_WGATES) + (size_t)e * 1536 * 8, WGEFF);
                } else {
                    conv_mat(F, cur, INP(I_CIN) + (size_t)e * DM * C_IN, DM, C_IN, C_IN, WIN, DM, 0, 1.f, MapId{0});
                    zero_bytes(F, WIN + (size_t)1248 * DM, (size_t)(C_INP - 1248) * DM * 2);
                    conv_mat(F, cur, INP(I_COUT) + (size_t)e * DM * DM, DM, DM, DM, WOUT, DM, 0, 1.f, MapId{0});
                    conv_mat(F, cur, INP(I_CUQ) + (size_t)e * 384 * 1024, 384, 1024, 1024, WUQ, 384, 0, 1.f, MapId{0});
                    for (int h = 0; h < 8; ++h) {
                        conv_mat(F, cur, INP(I_CUK) + ((size_t)e * 8 + h) * 256 * 128, 256, 128, 128, WUKV, 256, 0, 1.f, MapId{h * 128});
                        conv_mat(F, cur, INP(I_CUV) + ((size_t)e * 8 + h) * 256 * 128, 256, 128, 128, WUKV, 256, 0, 1.f, MapId{1024 + h * 128}); }
                }
            STEP_END
        }
        STEP_BEGIN
            run_gemm(F, XB, WGU + (size_t)f * 5632 * DM, M, 5632, DM, pg8::EpiSwiglu{ACT, FFN}, 0);
            if (f == 0) run_gemm(F, MEMN, WXKV, MROWS, 1024, DM, pg8::EpiPlain{KVX, 1024, 1.f}, 128);
        STEP_END
        STEP_BEGIN
            run_gemm(F, ACT, WDN + (size_t)f * DM * FFN, M, DM, FFN, pg8::EpiPlain{Y, DM, 1.f}, 0);
        STEP_END
        STEP_BEGIN
            const float* gpost = ng + (f == 0 ? 1 : 7) * DM;
            const float* gpre = f == 0 ? ng + 2 * DM : (l + 1 < DEPTH ? ng + 8 * DM : nullptr);
            t_norm(F, X, X, Y, 0.5f, gpost, gpre, XB);
        STEP_END
        if (f == 0) {
            STEP_BEGIN
                if (par == 0) run_gemm(F, XB, WIN, M, AB_INP, DM, pg8::EpiPlain{U, AB_INP, 1.f}, 0);
                else run_gemm(F, XB, WIN, M, C_INP, DM, pg8::EpiPlain{U, C_INP, 1.f}, 0);
            STEP_END
            STEP_BEGIN
                if (par == 0) t_prep_even(F, U, INP(I_ACQG) + (size_t)e * 384, INP(I_ACKVG) + (size_t)e * 256, ROPE, INP(I_CONVW) + (size_t)e * 4 * 512, INP(I_CONVB) + (size_t)e * 512,
                                          WGEFF, INP(I_BGATES) + (size_t)e * 8, CQN, CKVN, KR, XC, GATE);
                else t_prep_odd(F, U, INP(I_CCQG) + (size_t)e * 384, INP(I_CCKVG) + (size_t)e * 256, CQN, CKVN);
            STEP_END
            STEP_BEGIN
                if (par == 0) {
                    if (blockIdx.x < 32 && F.wave == 0) t_scan(F, GATE, FG, (int)blockIdx.x);
                    run_gemm(F, CQN, WUQ, M, 768, 384, pg8::EpiRopeQ{QA, 768, 0.07216878364870323f * LOG2E, ROPE}, 0);
                    run_gemm(F, CKVN, WUKV, M, 1024, 256, pg8::EpiPlain{KVA, 1024, 1.f}, 0);
                    run_gemm(F, XC, WQK, M, 1024, 512, pg8::EpiPlain{QKM, 1024, 1.f}, 0);
                } else {
                    run_gemm(F, CQN, WUQ, M, 1024, 384, pg8::EpiPlain{QA, 1024, 0.08838834764831845f * LOG2E}, 0);
                    run_gemm(F, CKVN, WUKV, M, 2048, 256, pg8::EpiPlain{KVA, 2048, 1.f}, 0);
                }
            STEP_END
            if (par == 1) {
                STEP_BEGIN
                    ph_indexer_simple(F, U, BM);
                STEP_END
            }
            STEP_BEGIN
                MK_AB(); if (par == 0) { ph_attn_simple<0, 4>(F, AB); ph_attn_simple<1, 4>(F, AB); }
                else ph_attn_simple<2, 8>(F, AB);
            STEP_END
            if (par == 0) {
                STEP_BEGIN
                    t_mix(F, HM, XC, U, INP(I_GNG) + (size_t)e * 512, INP(I_SKIP) + (size_t)e * 512, MIX);
                STEP_END
            }
            STEP_BEGIN
                run_gemm(F, MIX, WOUT, M, DM, DM, pg8::EpiPlain{Y, DM, 1.f}, 0);
            STEP_END
            STEP_BEGIN
                t_norm(F, X, X, Y, 1.0f, ng + 3 * DM, ng + 4 * DM, XB);
            STEP_END
            STEP_BEGIN
                run_gemm(F, XB, WXQ, M, 512, DM, pg8::EpiPlain{QX, 512, 0.08838834764831845f * LOG2E}, 0);
            STEP_END
            STEP_BEGIN
                MK_AB(); ph_attn_simple<3, 4>(F, AB);
            STEP_END
            STEP_BEGIN
                run_gemm(F, OX, WXO, M, DM, 512, pg8::EpiPlain{Y, DM, 1.f}, 0);
            STEP_END
            STEP_BEGIN
                t_norm(F, X, X, Y, 1.0f, ng + 5 * DM, ng + 6 * DM, XB);
            STEP_END
        }
    }
#undef STEP_BEGIN
#undef STEP_END
}

#ifndef MK_SPLIT
#define MK_SPLIT 0
#endif
constexpr int N_STEPS = 1 + DEPTH * (1 + 3 + 3 + 1 + 1 + 2 + 4 + 3) - 2;
extern "C" void kernel_launch(void* const* d_in, const int* in_sizes, int n_in, void* d_out, int out_size, void* d_ws, size_t ws_size, hipStream_t stream) {
    static int grid = 0;
    if (grid == 0) {
        if (n_in != 33 || in_sizes[0] != M * DM || out_size != M * DM || ws_size < WS_END) { fprintf(stderr, "kernel_launch: unexpected shapes (n_in %d, in0 %d, out %d, ws %zu < %zu)\n", n_in, n_in > 0 ? in_sizes[0] : -1, out_size, ws_size, (size_t)WS_END); grid = -1; return; }
        int dev = 0, cus = 0;
        if (hipGetDevice(&dev) != hipSuccess || hipDeviceGetAttribute(&cus, hipDeviceAttributeMultiprocessorCount, dev) != hipSuccess) { grid = -1; return; }
        if (hipFuncSetAttribute((const void*)mega_fwd, hipFuncAttributeMaxDynamicSharedMemorySize, LDS_BYTES) != hipSuccess) { fprintf(stderr, "kernel_launch: hipFuncSetAttribute failed\n"); grid = -1; return; }
        int per_cu = 0;
        if (hipOccupancyMaxActiveBlocksPerMultiprocessor(&per_cu, (const void*)mega_fwd, NWAVES * 64, LDS_BYTES) != hipSuccess || per_cu < 1) fprintf(stderr, "kernel_launch: occupancy query says %d\n", per_cu);
        (void)hipGetLastError();
        grid = cus;
    }
    if (grid < 0) return;
    Params p{};
    for (int i = 0; i < 33; ++i) p.in[i] = (const float*)d_in[i];
    p.out = (float*)d_out; p.ws = (unsigned char*)d_ws;
#if MK_SPLIT
    for (int s = 0; s < 200; ++s) { (void)hipMemsetAsync((char*)d_ws + WS_CTL, 0, CTL_BYTES, stream); p.st_lo = s; p.st_hi = s + 1; hipLaunchKernelGGL(mega_fwd, dim3(grid), dim3(NWAVES * 64), LDS_BYTES, stream, p); if (s + 1 >= N_STEPS) break; }
#else
    (void)hipMemsetAsync((char*)d_ws + WS_CTL, 0, CTL_BYTES, stream);
    p.st_lo = 0; p.st_hi = 1 << 20;
    hipLaunchKernelGGL(mega_fwd, dim3(grid), dim3(NWAVES * 64), LDS_BYTES, stream, p);
#endif
    const hipError_t le = hipPeekAtLastError();
    if (le != hipSuccess) fprintf(stderr, "kernel_launch: launch failed: %s\n", hipGetErrorName(le));
}
```

```cpp
#include <hip/hip_runtime.h>
#include <cstdio>
#include <cstdint>
namespace pg8 {
#define PG8_LAS __attribute__((address_space(3)))
typedef unsigned short bf16_t;
typedef short bf16x8 __attribute__((ext_vector_type(8)));
typedef float f32x4 __attribute__((ext_vector_type(4)));
typedef unsigned u32x4 __attribute__((ext_vector_type(4)));
constexpr int BM = 256, BK = 64, HALF = 128, HTB = HALF * BK * 2  , STAGE_BYTES = 8 * HTB, NXCD = 8, WGM = 8;

__host__ __device__ __forceinline__ int lds_byte(int r, int c) { const int st = (r >> 4) * 2 + (c >> 5), rr = r & 15, cc = c & 31, ob = rr * 64 + cc * 2; return st * 1024 + (ob ^ (((ob >> 9) & 1) << 5)); }
__host__ __device__ __forceinline__ void stage_rc(int b, int& R, int& C) { const int st = b / 1024, sb = b % 1024, swz = sb ^ (((sb >> 9) & 1) << 5); R = (st >> 1) * 16 + swz / 64; C = (st & 1) * 32 + (swz % 64) / 2; }
__host__ __device__ __forceinline__ int perm32(int rho) { const int n = rho >> 4, i = rho & 15; return 8 * (i >> 2) + 4 * n + (i & 3); }

struct Unit { int pm, pn; };
struct Gemm { const bf16_t* A; const bf16_t* Bt; int M, N, K; };

struct StaticOrder {
    int nM, nN, nwg, G, c;
    __host__ __device__ void init(int M, int N, int G_, int c_) { nM = M / BM; nN = N / BM; nwg = nM * nN; G = G_; c = c_; }
    __host__ __device__ bool next(int i, Unit& u) const {
        const long L = (long)i * G + c; if (L >= nwg) return false;
        int wgid = (int)L; { const int q = nwg / NXCD, r = nwg % NXCD, xcd = wgid % NXCD, off = wgid / NXCD; wgid = (xcd < r ? xcd * (q + 1) : r * (q + 1) + (xcd - r) * q) + off; }
        const int nig = WGM * nN, gid = wgid / nig, fm = gid * WGM, gsz = (nM - fm) < WGM ? (nM - fm) : WGM;
        u.pm = fm + ((wgid % nig) % gsz); u.pn = (wgid % nig) / gsz; return true;
    }
    __device__ __forceinline__ void a_ready(const Unit&) const {}
    __device__ __forceinline__ void done(const Unit&) const {}
};
__device__ __forceinline__ unsigned cvt_pk_bf16(float lo, float hi) { unsigned r; asm volatile("v_cvt_pk_bf16_f32 %0, %1, %2" : "=v"(r) : "v"(lo), "v"(hi)); return r; }
typedef float f32x2 __attribute__((ext_vector_type(2)));
typedef float f32x2 __attribute__((ext_vector_type(2)));
struct EpiPlain {
    static constexpr bool PERM = true, AFTER_DRAIN = false;
    bf16_t* O; int ldc; float scale;
    __device__ __forceinline__ void operator()(const f32x4 (&acc)[2][2][4][2], const Unit& u, int wr, int wc, int fr_, int fq_) const {
        int ln_; asm volatile("v_mbcnt_lo_u32_b32 %0, -1, 0\n\tv_mbcnt_hi_u32_b32 %0, -1, %0" : "=v"(ln_)); const int fr = ln_ & 15, fq = ln_ >> 4;
        const int row0 = u.pm * BM + wr * 64 + fr, col0 = u.pn * BM + wc * 32 + 8 * fq;
#pragma unroll
        for (int ai = 0; ai < 2; ++ai)
#pragma unroll
            for (int m = 0; m < 4; ++m) { bf16_t* rowp = O + (size_t)(row0 + ai * HALF + m * 16) * ldc + col0;
#pragma unroll
                for (int bj = 0; bj < 2; ++bj) { const f32x4 v0 = acc[ai][bj][m][0] * scale, v1 = acc[ai][bj][m][1] * scale;
                    u32x4 w; w.x = cvt_pk_bf16(v0[0], v0[1]); w.y = cvt_pk_bf16(v0[2], v0[3]); w.z = cvt_pk_bf16(v1[0], v1[1]); w.w = cvt_pk_bf16(v1[2], v1[3]);
                    *(u32x4*)(rowp + bj * HALF) = w; } }
    }
};
__device__ __forceinline__ float silu_mul(float g, float u) { return g * u * __builtin_amdgcn_rcpf(1.0f + __builtin_amdgcn_exp2f(-1.4426950408889634f * g)); }
struct EpiSwiglu {
    static constexpr bool PERM = true, AFTER_DRAIN = false;
    bf16_t* O; int ldc;
    __device__ __forceinline__ void operator()(const f32x4 (&acc)[2][2][4][2], const Unit& u, int wr, int wc, int fr_, int fq_) const {
        int ln_; asm volatile("v_mbcnt_lo_u32_b32 %0, -1, 0\n\tv_mbcnt_hi_u32_b32 %0, -1, %0" : "=v"(ln_)); const int fr = ln_ & 15, fq = ln_ >> 4;
        const int row0 = u.pm * BM + wr * 64 + fr, col0 = u.pn * HALF + wc * 32 + 8 * fq;
#pragma unroll
        for (int ai = 0; ai < 2; ++ai)
#pragma unroll
            for (int m = 0; m < 4; ++m) { bf16_t* rowp = O + (size_t)(row0 + ai * HALF + m * 16) * ldc + col0;
                const f32x4 g0 = acc[ai][0][m][0], g1 = acc[ai][0][m][1], u0 = acc[ai][1][m][0], u1 = acc[ai][1][m][1];
                u32x4 w; w.x = cvt_pk_bf16(silu_mul(g0[0], u0[0]), silu_mul(g0[1], u0[1])); w.y = cvt_pk_bf16(silu_mul(g0[2], u0[2]), silu_mul(g0[3], u0[3]));
                w.z = cvt_pk_bf16(silu_mul(g1[0], u1[0]), silu_mul(g1[1], u1[1])); w.w = cvt_pk_bf16(silu_mul(g1[2], u1[2]), silu_mul(g1[3], u1[3]));
                *(u32x4*)rowp = w; }
    }
};
struct EpiRopeQ {
    static constexpr bool PERM = true, AFTER_DRAIN = false;
    bf16_t* O; int ldc; float scale; const float* rope;
    __device__ __forceinline__ void operator()(const f32x4 (&acc)[2][2][4][2], const Unit& u, int wr, int wc, int fr_, int fq_) const {
        int ln_; asm volatile("v_mbcnt_lo_u32_b32 %0, -1, 0\n\tv_mbcnt_hi_u32_b32 %0, -1, %0" : "=v"(ln_)); const int fr = ln_ & 15, fq = ln_ >> 4;
        const int row0 = u.pm * BM + wr * 64 + fr, col0 = u.pn * BM + wc * 32 + 8 * fq;
#pragma unroll
        for (int ai = 0; ai < 2; ++ai)
#pragma unroll
            for (int m = 0; m < 4; ++m) { const int row = row0 + ai * HALF + m * 16; bf16_t* rowp = O + (size_t)row * ldc + col0;
#pragma unroll
                for (int bj = 0; bj < 2; ++bj) { f32x4 v0 = acc[ai][bj][m][0] * scale, v1 = acc[ai][bj][m][1] * scale;
                    const int w192 = (col0 + bj * HALF) % 192;
                    if (w192 >= 128) { const float* cs = rope + ((size_t)row * 32 + ((w192 - 128) >> 1)) * 2; const f32x4 c0 = *(const f32x4*)cs, c1 = *(const f32x4*)(cs + 4);
                        const f32x4 r0 = {v0[0] * c0[0] - v0[1] * c0[1], v0[0] * c0[1] + v0[1] * c0[0], v0[2] * c0[2] - v0[3] * c0[3], v0[2] * c0[3] + v0[3] * c0[2]};
                        const f32x4 r1 = {v1[0] * c1[0] - v1[1] * c1[1], v1[0] * c1[1] + v1[1] * c1[0], v1[2] * c1[2] - v1[3] * c1[3], v1[2] * c1[3] + v1[3] * c1[2]};
                        v0 = r0; v1 = r1; }
                    u32x4 w; w.x = cvt_pk_bf16(v0[0], v0[1]); w.y = cvt_pk_bf16(v0[2], v0[3]); w.z = cvt_pk_bf16(v1[0], v1[1]); w.w = cvt_pk_bf16(v1[2], v1[3]);
                    *(u32x4*)(rowp + bj * HALF) = w; } }
    }
};
template <class Epi, class Sched, bool ALIGN_EPI = false, bool SP2 = false>
__device__ __forceinline__ void gemm_phase(PG8_LAS unsigned char* lds, const Gemm g, const Sched& S, const Epi& E, const int wave_in) {
    int tid_o; asm volatile("v_mbcnt_lo_u32_b32 %0, -1, 0\n\tv_mbcnt_hi_u32_b32 %0, -1, %0" : "=v"(tid_o)); tid_o += 64 * wave_in; const int tid = tid_o, wid = __builtin_amdgcn_readfirstlane(tid >> 6), lane = tid & 63, wr = wid >> 2, wc = wid & 3, fr = lane & 15, fq = lane >> 4;
    const int K = g.K, nt = K / BK;
    unsigned voffA[2], voffB[2];
#pragma unroll
    for (int i = 0; i < 2; ++i) { int R, C; stage_rc(tid * 16 + i * 8192, R, C); const int Rb = Epi::PERM ? ((R & ~31) + perm32(R & 31)) : R;
        voffA[i] = (unsigned)(R * K + C) * 2u; voffB[i] = (unsigned)(Rb * K + C) * 2u; }
    const size_t kstep = (size_t)(BK * 2);
    const size_t hstep = (size_t)HALF * K * 2;
    const size_t tstep = 2 * hstep;
    const unsigned ldsw = (unsigned)wid * 1024u;
    const int aoff = lds_byte(wr * 64 + fr, fq * 8), boff = lds_byte(wc * 32 + fr, fq * 8);
#define PG8_SA(b, h) (((b) * 2 + (h)) * HTB)
#define PG8_SB(b, h) ((4 + (b) * 2 + (h)) * HTB)
#define PG8_STAGE(bufoff, gbase, voff) do { _Pragma("unroll") for (int _i = 0; _i < 2; ++_i) \
        __builtin_amdgcn_global_load_lds((const unsigned*)((const char*)(gbase) + (voff)[_i]), (PG8_LAS unsigned*)(lds + (bufoff) + ldsw + _i * 8192), 16, 0, 0); } while (0)
#define PG8_LDA(dst, b, h) do { _Pragma("unroll") for (int m = 0; m < 4; ++m) _Pragma("unroll") for (int k = 0; k < 2; ++k) dst[m][k] = *(const PG8_LAS bf16x8*)(lds + PG8_SA(b, h) + aoff + m * 2048 + k * 1024); } while (0)
#define PG8_LDB(dst, b, h) do { _Pragma("unroll") for (int n = 0; n < 2; ++n) _Pragma("unroll") for (int k = 0; k < 2; ++k) dst[n][k] = *(const PG8_LAS bf16x8*)(lds + PG8_SB(b, h) + boff + n * 2048 + k * 1024); } while (0)
#define PG8_MMA(ai, bj, At, Bt) do { __builtin_amdgcn_s_setprio(1); _Pragma("unroll") for (int m = 0; m < 4; ++m) _Pragma("unroll") for (int n = 0; n < 2; ++n) _Pragma("unroll") for (int k = 0; k < 2; ++k) \
        acc[ai][bj][m][n] = __builtin_amdgcn_mfma_f32_16x16x32_bf16(Bt[n][k], At[m][k], acc[ai][bj][m][n], 0, 0, 0); __builtin_amdgcn_s_setprio(0); } while (0)
#define PG8_WAIT_V(n) asm volatile("s_waitcnt vmcnt(" #n ")" ::: "memory")
#define PG8_WAIT_L(n) asm volatile("s_waitcnt lgkmcnt(" #n ")" ::: "memory")
#define PG8_BAR __builtin_amdgcn_s_barrier()
#define PG8_SCHED __builtin_amdgcn_sched_barrier(0)
    Unit cur, nxt; int ui = 0;
    if (!S.next(0, cur)) return;
    f32x4 acc[2][2][4][2];
#pragma unroll
    for (int a = 0; a < 2; ++a)
#pragma unroll
        for (int b = 0; b < 2; ++b)
#pragma unroll
            for (int m = 0; m < 4; ++m)
#pragma unroll
                for (int n = 0; n < 2; ++n) acc[a][b][m][n] = (f32x4){0.f, 0.f, 0.f, 0.f};
    bf16x8 At[4][2], B0[2][2], B1[2][2];
    const char* cA = (const char*)g.A + (size_t)cur.pm * tstep; const char* cB = (const char*)g.Bt + (size_t)cur.pn * tstep;
    S.a_ready(cur);
    if constexpr (SP2) {
        PG8_STAGE(PG8_SB(0, 0), cB, voffB); PG8_STAGE(PG8_SB(0, 1), cB + hstep, voffB); PG8_STAGE(PG8_SA(0, 0), cA, voffA); PG8_STAGE(PG8_SA(0, 1), cA + hstep, voffA);
        if (wr == 1) PG8_BAR;
        PG8_WAIT_V(2); PG8_BAR;
        PG8_STAGE(PG8_SB(1, 0), cB + kstep, voffB); PG8_STAGE(PG8_SA(1, 0), cA + kstep, voffA); PG8_STAGE(PG8_SB(1, 1), cB + hstep + kstep, voffB);
        PG8_WAIT_V(6); PG8_BAR;
    } else {
        PG8_STAGE(PG8_SB(0, 0), cB, voffB); PG8_STAGE(PG8_SA(0, 0), cA, voffA); PG8_STAGE(PG8_SB(0, 1), cB + hstep, voffB); PG8_STAGE(PG8_SA(0, 1), cA + hstep, voffA);
        if (wr == 1) PG8_BAR;
        PG8_WAIT_V(4); PG8_BAR;
        PG8_STAGE(PG8_SB(1, 0), cB + kstep, voffB); PG8_STAGE(PG8_SA(1, 0), cA + kstep, voffA); PG8_STAGE(PG8_SB(1, 1), cB + hstep + kstep, voffB);
        PG8_WAIT_V(6); PG8_BAR;
    }
    for (;;) {
        const bool has_next = S.next(ui + 1, nxt);
        const char* nA = has_next ? (const char*)g.A + (size_t)nxt.pm * tstep : cA; const char* nB = has_next ? (const char*)g.Bt + (size_t)nxt.pn * tstep : cB;
        for (int t = 0; t < nt; t += 2) {
            const bool last = (t == nt - 2);
            const char* a1 = cA + (size_t)(t + 1) * kstep;
            const char* a2 = last ? nA : cA + (size_t)(t + 2) * kstep; const char* b2 = last ? nB : cB + (size_t)(t + 2) * kstep;
            const char* a3 = a2 + kstep; const char* b3 = b2 + kstep;
            if (last && has_next) S.a_ready(nxt);
            if constexpr (SP2) {
            PG8_LDB(B0, 0, 0); PG8_LDB(B1, 0, 1); PG8_SCHED; PG8_LDA(At, 0, 0); PG8_STAGE(PG8_SA(1, 1), a1 + hstep, voffA);
            PG8_WAIT_V(8); PG8_WAIT_L(0); PG8_BAR; PG8_MMA(0, 0, At, B0); PG8_MMA(0, 1, At, B1); PG8_BAR; PG8_SCHED;
            PG8_LDA(At, 0, 1); PG8_STAGE(PG8_SB(0, 0), b2, voffB); PG8_STAGE(PG8_SB(0, 1), b2 + hstep, voffB); PG8_STAGE(PG8_SA(0, 0), a2, voffA);
            PG8_WAIT_V(8); PG8_WAIT_L(0); PG8_BAR; PG8_MMA(1, 0, At, B0); PG8_MMA(1, 1, At, B1); PG8_BAR; PG8_SCHED;
            PG8_LDB(B0, 1, 0); PG8_LDB(B1, 1, 1); PG8_SCHED; PG8_LDA(At, 1, 0); PG8_STAGE(PG8_SA(0, 1), a2 + hstep, voffA);
            PG8_WAIT_V(8); PG8_WAIT_L(0); PG8_BAR; PG8_MMA(0, 0, At, B0); PG8_MMA(0, 1, At, B1); PG8_BAR; PG8_SCHED;
            PG8_LDA(At, 1, 1); PG8_STAGE(PG8_SB(1, 0), b3, voffB); PG8_STAGE(PG8_SB(1, 1), b3 + hstep, voffB); PG8_STAGE(PG8_SA(1, 0), a3, voffA);
            PG8_WAIT_V(8); PG8_WAIT_L(0); PG8_BAR; PG8_MMA(1, 0, At, B0); PG8_MMA(1, 1, At, B1); PG8_BAR; PG8_SCHED;
            } else {
            PG8_LDB(B0, 0, 0); PG8_SCHED; PG8_LDA(At, 0, 0); PG8_STAGE(PG8_SA(1, 1), a1 + hstep, voffA);
            PG8_WAIT_L(8); PG8_BAR; PG8_WAIT_L(0); PG8_MMA(0, 0, At, B0); PG8_BAR; PG8_SCHED;
            PG8_LDB(B1, 0, 1); PG8_STAGE(PG8_SB(0, 0), b2, voffB);
            PG8_BAR; PG8_WAIT_L(0); PG8_MMA(0, 1, At, B1); PG8_BAR;
            PG8_LDA(At, 0, 1); PG8_STAGE(PG8_SA(0, 0), a2, voffA);
            PG8_BAR; PG8_WAIT_L(0); PG8_MMA(1, 0, At, B0); PG8_BAR; PG8_SCHED;
            PG8_STAGE(PG8_SB(0, 1), b2 + hstep, voffB);
            PG8_WAIT_V(6); PG8_BAR; PG8_MMA(1, 1, At, B1); PG8_BAR;
            PG8_LDB(B0, 1, 0); PG8_SCHED; PG8_LDA(At, 1, 0); PG8_STAGE(PG8_SA(0, 1), a2 + hstep, voffA);
            PG8_WAIT_L(8); PG8_BAR; PG8_WAIT_L(0); PG8_MMA(0, 0, At, B0); PG8_BAR; PG8_SCHED;
            PG8_LDB(B1, 1, 1); PG8_STAGE(PG8_SB(1, 0), b3, voffB);
            PG8_BAR; PG8_WAIT_L(0); PG8_MMA(0, 1, At, B1); PG8_BAR;
            PG8_LDA(At, 1, 1); PG8_STAGE(PG8_SA(1, 0), a3, voffA);
            PG8_BAR; PG8_WAIT_L(0); PG8_MMA(1, 0, At, B0); PG8_BAR; PG8_SCHED;
            PG8_STAGE(PG8_SB(1, 1), b3 + hstep, voffB);
            PG8_WAIT_V(6); PG8_BAR; PG8_MMA(1, 1, At, B1); PG8_BAR;
            }
        }
        if constexpr (ALIGN_EPI) { if (wr == 0) PG8_BAR; }
        if constexpr (!Epi::AFTER_DRAIN) { E(acc, cur, wr, wc, fr, fq); S.done(cur); }
        if (!has_next) break;
#pragma unroll
        for (int a = 0; a < 2; ++a)
#pragma unroll
            for (int b = 0; b < 2; ++b)
#pragma unroll
                for (int m = 0; m < 4; ++m)
#pragma unroll
                    for (int n = 0; n < 2; ++n) acc[a][b][m][n] = (f32x4){0.f, 0.f, 0.f, 0.f};
        cur = nxt; cA = nA; cB = nB; ++ui;
        if constexpr (ALIGN_EPI) { if (wr == 1) PG8_BAR; }
    }
    PG8_WAIT_V(0);
    if constexpr (!ALIGN_EPI) { if (wr == 0) PG8_BAR; }
    PG8_BAR;
    if constexpr (Epi::AFTER_DRAIN) { E.fused(acc, cur, wr, wc, fr, fq, lds, wid, lane); S.done(cur); }
#undef PG8_SA
#undef PG8_SB
#undef PG8_STAGE
#undef PG8_LDA
#undef PG8_LDB
#undef PG8_MMA
#undef PG8_WAIT_V
#undef PG8_WAIT_L
#undef PG8_BAR
#undef PG8_SCHED
}
}
constexpr int NWAVES = 8;
constexpr int BATCH = 8, SEQ = 2048, DM = 1024, M = BATCH * SEQ, FFN = 2816, NMEM = 256, DEPTH = 4;
constexpr int MROWS = BATCH * NMEM;
constexpr int AB_IN = 2240, AB_INP = 2304, C_IN = 1224, C_INP = 1280;
constexpr float EPS = 1e-6f;
constexpr float LOG2E = 1.4426950408889634f;
constexpr int U_CQ = 0, U_CKV = 384, U_KR = 640, U_XM = 704, U_VM = 1216, U_OG = 1728;
constexpr int V_CQ = 0, V_CKV = 384, V_QI = 640, V_KI = 1152, V_WI = 1216;

constexpr size_t MiB = 1u << 20;
constexpr size_t WS_CTL = 0, CTL_BYTES = 1 * MiB;
constexpr size_t WS_WGU = 1 * MiB;
constexpr size_t WS_WDN = WS_WGU + 22 * MiB;
constexpr size_t WS_WXQ = WS_WDN + 11 * MiB;
constexpr size_t WS_WXKV = WS_WXQ + 1 * MiB;
constexpr size_t WS_WXO = WS_WXKV + 2 * MiB;
constexpr size_t WS_WIN = WS_WXO + 1 * MiB;
constexpr size_t WS_WOUT = WS_WIN + 5 * MiB;
constexpr size_t WS_WUQ = WS_WOUT + 2 * MiB;
constexpr size_t WS_WUKV = WS_WUQ + 1 * MiB;
constexpr size_t WS_WQK = WS_WUKV + 1 * MiB;
constexpr size_t WS_WGEFF = WS_WQK + 1 * MiB;
constexpr size_t WS_MEMN = WS_WGEFF + 1 * MiB;
constexpr size_t WS_KVX = WS_MEMN + 4 * MiB;
constexpr size_t WS_ROPE = WS_KVX + 4 * MiB;
constexpr size_t WS_XB = WS_ROPE + 4 * MiB;
constexpr size_t WS_Y = WS_XB + 32 * MiB;
constexpr size_t WS_BIG = WS_Y + 32 * MiB;
constexpr size_t WS_ACT = WS_BIG;
constexpr size_t WS_U = WS_BIG;
constexpr size_t WS_CQN = WS_U + 72 * MiB;
constexpr size_t WS_CKVN = WS_CQN + 12 * MiB;
constexpr size_t WS_KR = WS_CKVN + 8 * MiB;
constexpr size_t WS_XC = WS_KR + 2 * MiB;
constexpr size_t WS_GATE = WS_XC + 16 * MiB;
constexpr size_t WS_FG = WS_GATE + 1 * MiB;
constexpr size_t WS_QA = WS_FG + 1 * MiB;
constexpr size_t WS_KVA = WS_QA + 32 * MiB;
constexpr size_t WS_QKM = WS_KVA + 64 * MiB;
constexpr size_t WS_HM = WS_QKM + 32 * MiB;
constexpr size_t WS_MIX = WS_HM + 16 * MiB;
constexpr size_t WS_BM = WS_MIX + 32 * MiB;
constexpr size_t WS_QX = WS_U;
constexpr size_t WS_OX = WS_U + 16 * MiB;
constexpr size_t WS_END = WS_BM + 4 * MiB;
static_assert(WS_ACT + (size_t)M * FFN * 2 <= WS_END, "ACT fits the big region");
static_assert(WS_END <= 440 * MiB, "d_ws budget");
constexpr int CW_BAR = 4096;

constexpr int RING_BYTES = 131072;
constexpr int LDSCTL_OFF = RING_BYTES, MISC_OFF = LDSCTL_OFF + 320;
constexpr int LDS_BYTES = 147456;

#define GAS __attribute__((address_space(1)))
#define LAS __attribute__((address_space(3)))
typedef unsigned short bf16;
typedef unsigned v4u __attribute__((ext_vector_type(4)));
typedef unsigned v2u __attribute__((ext_vector_type(2)));
typedef float f32x4 __attribute__((ext_vector_type(4)));
#define LDS_WAIT() asm volatile("s_waitcnt lgkmcnt(0)" ::: "memory")
#define VM_WAIT() asm volatile("s_waitcnt vmcnt(0)" ::: "memory")
__device__ __forceinline__ unsigned f2bf(float f) { unsigned u = __builtin_bit_cast(unsigned, f); return (u + 0x7fffu + ((u >> 16) & 1u)) >> 16; }
__device__ __forceinline__ unsigned pk2(float lo, float hi) { return f2bf(lo) | (f2bf(hi) << 16); }
__device__ __forceinline__ float bflo(unsigned w) { return __uint_as_float(w << 16); }
__device__ __forceinline__ float bfhi(unsigned w) { return __uint_as_float(w & 0xffff0000u); }
__device__ __forceinline__ float bf2f(bf16 b) { return __uint_as_float((unsigned)b << 16); }
__device__ __forceinline__ void unpack8(const v4u w, float (&f)[8]) { f[0] = bflo(w.x); f[1] = bfhi(w.x); f[2] = bflo(w.y); f[3] = bfhi(w.y); f[4] = bflo(w.z); f[5] = bfhi(w.z); f[6] = bflo(w.w); f[7] = bfhi(w.w); }
__device__ __forceinline__ v4u pack8(const float (&f)[8]) { v4u w; w.x = pk2(f[0], f[1]); w.y = pk2(f[2], f[3]); w.z = pk2(f[4], f[5]); w.w = pk2(f[6], f[7]); return w; }
#define SWZ_XOR(v, x) __uint_as_float((unsigned)__builtin_amdgcn_ds_swizzle((int)__float_as_uint(v), 0x1f | ((x) << 10)))
__device__ __forceinline__ float wave_sum(float v) {
    v += SWZ_XOR(v, 1); v += SWZ_XOR(v, 2); v += SWZ_XOR(v, 4); v += SWZ_XOR(v, 8); v += SWZ_XOR(v, 16);
    const auto rr = __builtin_amdgcn_permlane32_swap(__float_as_uint(v), __float_as_uint(v), false, false);
    return __uint_as_float(rr[0]) + __uint_as_float(rr[1]);
}
__device__ __forceinline__ float wave_max(float v) {
    v = fmaxf(v, SWZ_XOR(v, 1)); v = fmaxf(v, SWZ_XOR(v, 2)); v = fmaxf(v, SWZ_XOR(v, 4)); v = fmaxf(v, SWZ_XOR(v, 8)); v = fmaxf(v, SWZ_XOR(v, 16));
    const auto rr = __builtin_amdgcn_permlane32_swap(__float_as_uint(v), __float_as_uint(v), false, false);
    return fmaxf(__uint_as_float(rr[0]), __uint_as_float(rr[1]));
}
__device__ __forceinline__ float rdlane(float v, int l) { return __uint_as_float((unsigned)__builtin_amdgcn_readlane((int)__float_as_uint(v), l)); }
#define XB_TMO      128
#define XB_XCNT(j)  (256  + 64 * (j))
#define XB_XSUB(j)  (1280 + 64 * (j))
#define XB_XGEN(j)  (2304 + 64 * (j))
#define XB_TOP      3328
#define XB_TOPGEN   3392
#define XCD_BAR_WORDS 3456
#define XB_SPIN_CAP (1u << 18)

__device__ __forceinline__ unsigned xb_ld(unsigned* p)              { return __hip_atomic_load(p, __ATOMIC_RELAXED, __HIP_MEMORY_SCOPE_AGENT); }
__device__ __forceinline__ unsigned xb_add(unsigned* p, unsigned v) { return __hip_atomic_fetch_add(p, v, __ATOMIC_RELAXED, __HIP_MEMORY_SCOPE_AGENT); }
__device__ __forceinline__ unsigned xb_xcc_id() { return (unsigned)__builtin_amdgcn_s_getreg((3 << 11) | 20) & 0xFu; }
#define XB_SPIN(cond, bar) do { unsigned _sp = 0; while (cond) { __builtin_amdgcn_s_sleep(1); \
    if ((++_sp & 255u) == 0u) { if (xb_ld(&(bar)[XB_TMO])) break; if (_sp > XB_SPIN_CAP) { atomicAdd(&(bar)[XB_TMO], 1u); break; } } } } while (0)

struct XcdBarrier {
    unsigned* bar; unsigned x;
    volatile LAS unsigned* st;
};

__device__ __forceinline__ XcdBarrier xcd_barrier_post(unsigned* bar, volatile LAS unsigned* st) {
    XcdBarrier b; b.bar = bar; b.x = xb_xcc_id(); b.st = st;
    if (threadIdx.x == 0) (void)xb_add(&bar[XB_XCNT(b.x)], 1u);
    return b;
}
__device__ __forceinline__ void xcd_barrier_complete(unsigned* bar, unsigned x, unsigned& nloc, unsigned& nx) {
    const unsigned G = gridDim.x * gridDim.y * gridDim.z;
    unsigned sum, cnt, mine, sp = 0u;
    for (;;) {
        sum = 0u; cnt = 0u; mine = 0u;
#pragma unroll
        for (unsigned j = 0; j < 16; ++j) { const unsigned c = xb_ld(&bar[XB_XCNT(j)]); sum += c; cnt += (c > 0u) ? 1u : 0u; mine = (j == x) ? c : mine; }
        if (sum == G) break;
        __builtin_amdgcn_s_sleep(1);
        if ((++sp & 255u) == 0u) { if (xb_ld(&bar[XB_TMO])) break; if (sp > XB_SPIN_CAP) { atomicAdd(&bar[XB_TMO], 1u); break; } }
    }
    nloc = mine > 0u ? mine : 1u; nx = cnt > 0u ? cnt : 1u;
}

__device__ __forceinline__ void xcd_barrier(const XcdBarrier& b) {
    asm volatile("s_waitcnt vmcnt(0)" ::: "memory");
    __syncthreads();
    if (threadIdx.x == 0) {
        unsigned* bar = b.bar; asm volatile("" : "+s"(bar));
        __builtin_amdgcn_s_waitcnt(0);
        unsigned nloc = b.st[0], nx = b.st[1];
        if (nloc == 0u) { xcd_barrier_complete(bar, b.x, nloc, nx); b.st[0] = nloc; b.st[1] = nx; }
        const unsigned old = xb_add(&bar[XB_XSUB(b.x)], 1u);
        const unsigned gen = old / nloc;
        if (old + 1u == (gen + 1u) * nloc) {
            __builtin_amdgcn_fence(__ATOMIC_RELEASE, "agent");
            asm volatile("s_waitcnt vmcnt(0)" ::: "memory");
            const unsigned og = xb_add(&bar[XB_TOP], 1u);
            const unsigned tg = og / nx;
            if (og + 1u == (tg + 1u) * nx) xb_add(&bar[XB_TOPGEN], 1u);
            else XB_SPIN(xb_ld(&bar[XB_TOPGEN]) == tg, bar);
            __builtin_amdgcn_fence(__ATOMIC_ACQUIRE, "agent");
            xb_add(&bar[XB_XGEN(b.x)], 1u);
            asm volatile("s_waitcnt vmcnt(0)" ::: "memory");
        } else {
            XB_SPIN(xb_ld(&bar[XB_XGEN(b.x)]) == gen, bar);
            __builtin_amdgcn_fence(__ATOMIC_ACQUIRE, "agent");
            asm volatile("s_waitcnt vmcnt(0)" ::: "memory");
        }
    }
    __syncthreads();
}
struct Params { const float* in[33]; float* out; unsigned char* ws; int st_lo, st_hi; };
struct Frame { LAS unsigned char* lds; int tid, lane, wave, G, gw, NGW; };
enum { I_X = 0, I_MEM, I_POS, I_NORMG, I_MEMG, I_WG, I_WU, I_WD, I_XQ, I_XK, I_XV, I_XO, I_ABIN, I_ABOUT, I_ACQG, I_ACKVG, I_AUQ, I_AUKV, I_CONVW, I_CONVB, I_MLWQ, I_MLWK,
       I_WGATES, I_BGATES, I_GNG, I_SKIP, I_CIN, I_COUT, I_CCQG, I_CCKVG, I_CUQ, I_CUK, I_CUV };

struct MapId { int off; __device__ __forceinline__ int operator()(int n) const { return off + n; } };
struct MapGU { int off; __device__ __forceinline__ int operator()(int n) const { return ((n >> 7) << 8) + (n & 127) + off; } };
struct MapRopeQ { __device__ __forceinline__ int operator()(int n) const { const int h = n / 192, w = n % 192; return w < 128 ? n : h * 192 + 128 + 2 * ((w - 128) & 31) + ((w - 128) >> 5); } };
template <class Map>
__device__ __forceinline__ void tr_item(const float* __restrict__ W, int ldw, int Nvalid, int k0, int n0, bf16* WT, int ldt, int dcol0, float scale, const Map& map, LAS float* scr, int lane) {
    const int nn = lane & 31; const bool ok = (n0 + nn) < Nvalid;
#pragma unroll 8
    for (int i = 0; i < 32; ++i) { const int kk = 2 * i + (lane >> 5); scr[kk * 33 + nn] = ok ? W[(size_t)(k0 + kk) * ldw + n0 + nn] * scale : 0.f; }
    LDS_WAIT(); asm volatile("" ::: "memory");
    const int c = lane & 7;
#pragma unroll
    for (int j = 0; j < 4; ++j) { const int n = (lane >> 3) + 8 * j; const LAS float* s = scr + (8 * c) * 33 + n;
        v4u o; o.x = pk2(s[0 * 33], s[1 * 33]); o.y = pk2(s[2 * 33], s[3 * 33]); o.z = pk2(s[4 * 33], s[5 * 33]); o.w = pk2(s[6 * 33], s[7 * 33]);
        *(v4u*)(WT + (size_t)map(n0 + n) * ldt + dcol0 + k0 + 8 * c) = o; }
    LDS_WAIT(); asm volatile("" ::: "memory");
}
template <class Map>
__device__ __forceinline__ void conv_mat(const Frame& F, int& cur, const float* W, int K, int N, int ldw, bf16* WT, int ldt, int dcol0, float scale, const Map& map) {
    LAS float* scr = (LAS float*)(F.lds + F.wave * 16384);
    const int nblk = (N + 31) / 32, nitems = (K / 64) * nblk;
    int first = F.gw - cur; if (first < 0) first += F.NGW;
    for (int it = first; it < nitems; it += F.NGW) { const int kb = it / nblk, nb = it % nblk; tr_item(W, ldw, N, 64 * kb, 32 * nb, WT, ldt, dcol0, scale, map, scr, F.lane); }
    cur = (cur + nitems) % F.NGW;
}
__device__ __forceinline__ void zero_bytes(const Frame& F, void* p, size_t nbytes) {
    const size_t n16 = nbytes / 16; unsigned zz = 0u; asm volatile("" : "+v"(zz)); const v4u z = {zz, zz, zz, zz};
    for (size_t i = (size_t)blockIdx.x * 512 + F.tid; i < n16; i += (size_t)F.G * 512) ((v4u*)p)[i] = z;
}

__device__ __forceinline__ void ld_row_f32(const float* p, int lane, float (&v)[16]) {
#pragma unroll
    for (int j = 0; j < 2; ++j) { const f32x4 a = *(const f32x4*)(p + 512 * j + 8 * lane), b = *(const f32x4*)(p + 512 * j + 8 * lane + 4);
        v[8 * j + 0] = a[0]; v[8 * j + 1] = a[1]; v[8 * j + 2] = a[2]; v[8 * j + 3] = a[3]; v[8 * j + 4] = b[0]; v[8 * j + 5] = b[1]; v[8 * j + 6] = b[2]; v[8 * j + 7] = b[3]; }
}
__device__ __forceinline__ void st_row_f32(float* p, int lane, const float (&v)[16]) {
#pragma unroll
    for (int j = 0; j < 2; ++j) { *(f32x4*)(p + 512 * j + 8 * lane) = (f32x4){v[8 * j + 0], v[8 * j + 1], v[8 * j + 2], v[8 * j + 3]}; *(f32x4*)(p + 512 * j + 8 * lane + 4) = (f32x4){v[8 * j + 4], v[8 * j + 5], v[8 * j + 6], v[8 * j + 7]}; }
}
__device__ __forceinline__ void ld_row_bf16(const bf16* p, int lane, float (&v)[16]) {
#pragma unroll
    for (int j = 0; j < 2; ++j) { const v4u w = *(const v4u*)(p + 512 * j + 8 * lane); float f[8]; unpack8(w, f);
#pragma unroll
        for (int e = 0; e < 8; ++e) v[8 * j + e] = f[e]; }
}
__device__ __forceinline__ void st_row_bf16(bf16* p, int lane, const float (&v)[16]) {
#pragma unroll
    for (int j = 0; j < 2; ++j) { v4u w; w.x = pk2(v[8 * j + 0], v[8 * j + 1]); w.y = pk2(v[8 * j + 2], v[8 * j + 3]); w.z = pk2(v[8 * j + 4], v[8 * j + 5]); w.w = pk2(v[8 * j + 6], v[8 * j + 7]); *(v4u*)(p + 512 * j + 8 * lane) = w; }
}
__device__ __forceinline__ float ssq16(const float (&v)[16]) { float s = 0.f;
#pragma unroll
    for (int e = 0; e < 16; ++e) s += v[e] * v[e];
    return wave_sum(s); }
__device__ __forceinline__ void t_norm(const Frame& F, const float* xin, float* xout, const bf16* Y, float cmul, const float* gpost, const float* gpre, bf16* XB) {
    for (int m = F.gw; m < M; m += F.NGW) {
        float x[16]; ld_row_f32(xin + (size_t)m * DM, F.lane, x);
        if (Y) { float y[16], g[16]; ld_row_bf16(Y + (size_t)m * DM, F.lane, y); ld_row_f32(gpost, F.lane, g);
            const float rs = cmul * __builtin_amdgcn_rsqf(ssq16(y) * (1.0f / DM) + EPS);
#pragma unroll
            for (int e = 0; e < 16; ++e) x[e] += y[e] * rs * g[e]; }
        st_row_f32(xout + (size_t)m * DM, F.lane, x);
        if (gpre) { float g[16]; ld_row_f32(gpre, F.lane, g); const float rs = __builtin_amdgcn_rsqf(ssq16(x) * (1.0f / DM) + EPS);
#pragma unroll
            for (int e = 0; e < 16; ++e) x[e] = x[e] * rs * g[e];
            st_row_bf16(XB + (size_t)m * DM, F.lane, x); }
    }
}
__device__ __forceinline__ void t_memn(const Frame& F, const float* mem, const float* g, bf16* MEMN) {
    for (int m = F.gw; m < MROWS; m += F.NGW) { float x[16], gg[16]; ld_row_f32(mem + (size_t)m * DM, F.lane, x); ld_row_f32(g, F.lane, gg);
        const float rs = __builtin_amdgcn_rsqf(ssq16(x) * (1.0f / DM) + EPS);
#pragma unroll
        for (int e = 0; e < 16; ++e) x[e] = x[e] * rs * gg[e];
        st_row_bf16(MEMN + (size_t)m * DM, F.lane, x); }
}
__device__ __forceinline__ void t_rope_table(const Frame& F, const int* pos, float* ROPE) {
    for (int idx = blockIdx.x * 512 + F.tid; idx < M * 32; idx += F.G * 512) { const int m = idx >> 5, i = idx & 31;
        const float inv = __builtin_amdgcn_exp2f(-(float)i * (13.287712379549449f / 32.0f));
        const double rev = (double)pos[m] * (double)inv * 0.15915494309189535;
        const float fr = (float)(rev - __builtin_floor(rev));
        ROPE[2 * idx] = __builtin_amdgcn_cosf(fr); ROPE[2 * idx + 1] = __builtin_amdgcn_sinf(fr); }
}
__device__ __forceinline__ void t_weff(const Frame& F, const float* wq, const float* wk, const float* wg, float* WGEFF) {
    for (int idx = blockIdx.x * 512 + F.tid; idx < 1024 * 8; idx += F.G * 512) { const int k = idx >> 3, g = idx & 7; float s;
        if (k < 512) { const int h = k >> 7, d = k & 127; const float* q = wq + ((size_t)h * 128 + d) * 128; const float* kk = wk + ((size_t)h * 128 + d) * 128; s = 0.f;
            for (int e = 0; e < 128; ++e) s += q[e] * wg[(size_t)(h * 128 + e) * 8 + g] + kk[e] * wg[(size_t)(512 + h * 128 + e) * 8 + g]; }
        else s = wg[(size_t)(1024 + (k - 512)) * 8 + g];
        WGEFF[idx] = s; }
}
__device__ __forceinline__ float log_sigmoid(float x) {
    const float y = __expf(-fabsf(x));
    const float l1p = (y < 0.02f) ? y * (1.0f - y * (0.5f - y * (0.33333333f - 0.25f * y))) : __logf(1.0f + y);
    return fminf(x, 0.f) - l1p;
}
__device__ __forceinline__ void t_prep_even(const Frame& F, const bf16* U, const float* cqg, const float* ckvg, const float* ROPE, const float* convw, const float* convb,
                                            const float* WGEFF, const float* bgates, bf16* CQN, bf16* CKVN, bf16* KR, bf16* XC, float* GATE) {
    const int lane = F.lane;
    for (int m = F.gw; m < M; m += F.NGW) { const bf16* u = U + (size_t)m * AB_INP; const int t = m & (SEQ - 1);
        { float v[8]; float s = 0.f; if (lane < 48) { unpack8(*(const v4u*)(u + U_CQ + 8 * lane), v);
#pragma unroll
                for (int e = 0; e < 8; ++e) s += v[e] * v[e]; }
          const float rs = __builtin_amdgcn_rsqf(wave_sum(s) * (1.0f / 384.0f) + EPS);
          if (lane < 48) { const f32x4 g0 = *(const f32x4*)(cqg + 8 * lane), g1 = *(const f32x4*)(cqg + 8 * lane + 4);
              float o[8] = {v[0] * rs * g0[0], v[1] * rs * g0[1], v[2] * rs * g0[2], v[3] * rs * g0[3], v[4] * rs * g1[0], v[5] * rs * g1[1], v[6] * rs * g1[2], v[7] * rs * g1[3]};
              *(v4u*)(CQN + (size_t)m * 384 + 8 * lane) = pack8(o); } }
        { float v[8]; float s = 0.f; if (lane < 32) { unpack8(*(const v4u*)(u + U_CKV + 8 * lane), v);
#pragma unroll
                for (int e = 0; e < 8; ++e) s += v[e] * v[e]; }
          const float rs = __builtin_amdgcn_rsqf(wave_sum(s) * (1.0f / 256.0f) + EPS);
          if (lane < 32) { const f32x4 g0 = *(const f32x4*)(ckvg + 8 * lane), g1 = *(const f32x4*)(ckvg + 8 * lane + 4);
              float o[8] = {v[0] * rs * g0[0], v[1] * rs * g0[1], v[2] * rs * g0[2], v[3] * rs * g0[3], v[4] * rs * g1[0], v[5] * rs * g1[1], v[6] * rs * g1[2], v[7] * rs * g1[3]};
              *(v4u*)(CKVN + (size_t)m * 256 + 8 * lane) = pack8(o); } }
        if (lane < 32) { const float x1 = bf2f(u[U_KR + lane]), x2 = bf2f(u[U_KR + 32 + lane]); const float c = ROPE[((size_t)m * 32 + lane) * 2], sn = ROPE[((size_t)m * 32 + lane) * 2 + 1];
            *(unsigned*)(KR + (size_t)m * 64 + 2 * lane) = pk2(x1 * c - x2 * sn, x1 * sn + x2 * c); }
        float xc[8];
        { const f32x4 b0 = *(const f32x4*)(convb + 8 * lane), b1 = *(const f32x4*)(convb + 8 * lane + 4);
          float a[8] = {b0[0], b0[1], b0[2], b0[3], b1[0], b1[1], b1[2], b1[3]};
#pragma unroll
          for (int j = 0; j < 4; ++j) { if (t - 3 + j >= 0) { float v[8]; unpack8(*(const v4u*)(u + (ptrdiff_t)(j - 3) * AB_INP + U_XM + 8 * lane), v);
                  const f32x4 w0 = *(const f32x4*)(convw + j * 512 + 8 * lane), w1 = *(const f32x4*)(convw + j * 512 + 8 * lane + 4);
                  a[0] += v[0] * w0[0]; a[1] += v[1] * w0[1]; a[2] += v[2] * w0[2]; a[3] += v[3] * w0[3]; a[4] += v[4] * w1[0]; a[5] += v[5] * w1[1]; a[6] += v[6] * w1[2]; a[7] += v[7] * w1[3]; } }
#pragma unroll
          for (int e = 0; e < 8; ++e) xc[e] = a[e] * __builtin_amdgcn_rcpf(1.0f + __expf(-a[e]));
          *(v4u*)(XC + (size_t)m * 512 + 8 * lane) = pack8(xc); }
        { float vm[8]; unpack8(*(const v4u*)(u + U_VM + 8 * lane), vm); float gs[8];
#pragma unroll
          for (int g = 0; g < 8; ++g) gs[g] = 0.f;
#pragma unroll
          for (int e = 0; e < 8; ++e) { const f32x4 a0 = *(const f32x4*)(WGEFF + (size_t)(8 * lane + e) * 8), a1 = *(const f32x4*)(WGEFF + (size_t)(8 * lane + e) * 8 + 4);
              const f32x4 c0 = *(const f32x4*)(WGEFF + (size_t)(512 + 8 * lane + e) * 8), c1 = *(const f32x4*)(WGEFF + (size_t)(512 + 8 * lane + e) * 8 + 4);
              gs[0] += xc[e] * a0[0] + vm[e] * c0[0]; gs[1] += xc[e] * a0[1] + vm[e] * c0[1]; gs[2] += xc[e] * a0[2] + vm[e] * c0[2]; gs[3] += xc[e] * a0[3] + vm[e] * c0[3];
              gs[4] += xc[e] * a1[0] + vm[e] * c1[0]; gs[5] += xc[e] * a1[1] + vm[e] * c1[1]; gs[6] += xc[e] * a1[2] + vm[e] * c1[2]; gs[7] += xc[e] * a1[3] + vm[e] * c1[3]; }
#pragma unroll
          for (int g = 0; g < 8; ++g) gs[g] = wave_sum(gs[g]) + bgates[g];
          if (lane == 0) { *(f32x4*)(GATE + (size_t)m * 8) = (f32x4){gs[0], gs[1], gs[2], gs[3]};
              *(f32x4*)(GATE + (size_t)m * 8 + 4) = (f32x4){log_sigmoid(gs[4]), log_sigmoid(gs[5]), log_sigmoid(gs[6]), log_sigmoid(gs[7])}; } }
    }
}
__device__ __forceinline__ void t_scan(const Frame& F, const float* GATE, float* FG, int seq) {
    const int b = seq >> 2, h = seq & 3, lane = F.lane; const size_t m0 = (size_t)b * SEQ + 32 * lane;
    float lf[32]; float run = 0.f;
#pragma unroll
    for (int i = 0; i < 32; ++i) { run += GATE[(m0 + i) * 8 + 4 + h]; lf[i] = run; }
    float pre = run;
#pragma unroll
    for (int o = 1; o < 64; o <<= 1) { const float t = __uint_as_float((unsigned)__builtin_amdgcn_ds_bpermute((lane - o) * 4, (int)__float_as_uint(pre))); if (lane >= o) pre += t; }
    const float base = pre - run;
#pragma unroll
    for (int i = 0; i < 32; ++i) { const float Fv = base + lf[i]; const float li = GATE[(m0 + i) * 8 + h];
        FG[((m0 + i) * 4 + h) * 2] = Fv * LOG2E; FG[((m0 + i) * 4 + h) * 2 + 1] = (li - Fv) * LOG2E; }
}
__device__ __forceinline__ void t_mix(const Frame& F, const bf16* HM, const bf16* XC, const bf16* U, const float* gng, const float* skip, bf16* MIX) {
    const int lane = F.lane;
    for (int m = F.gw; m < M; m += F.NGW) { float h[8], xc[8], og[8];
        unpack8(*(const v4u*)(HM + (size_t)m * 512 + 8 * lane), h); unpack8(*(const v4u*)(XC + (size_t)m * 512 + 8 * lane), xc); unpack8(*(const v4u*)(U + (size_t)m * AB_INP + U_OG + 8 * lane), og);
        float s = 0.f;
#pragma unroll
        for (int e = 0; e < 8; ++e) s += h[e];
        s += SWZ_XOR(s, 1); s += SWZ_XOR(s, 2); s += SWZ_XOR(s, 4); s += SWZ_XOR(s, 8);
        const float mu = s * (1.0f / 128.0f); float q = 0.f;
#pragma unroll
        for (int e = 0; e < 8; ++e) { h[e] -= mu; q += h[e] * h[e]; }
        q += SWZ_XOR(q, 1); q += SWZ_XOR(q, 2); q += SWZ_XOR(q, 4); q += SWZ_XOR(q, 8);
        const float rs = __builtin_amdgcn_rsqf(q * (1.0f / 128.0f) + EPS);
        const f32x4 g0 = *(const f32x4*)(gng + 8 * lane), g1 = *(const f32x4*)(gng + 8 * lane + 4), k0 = *(const f32x4*)(skip + 8 * lane), k1 = *(const f32x4*)(skip + 8 * lane + 4);
        const float gg[8] = {g0[0], g0[1], g0[2], g0[3], g1[0], g1[1], g1[2], g1[3]}, kk[8] = {k0[0], k0[1], k0[2], k0[3], k1[0], k1[1], k1[2], k1[3]}; float o[8];
#pragma unroll
        for (int e = 0; e < 8; ++e) o[e] = (h[e] * rs * gg[e] + kk[e] * xc[e]) * __builtin_amdgcn_rcpf(1.0f + __expf(-og[e]));
        *(v4u*)(MIX + (size_t)m * DM + 512 + 8 * lane) = pack8(o); }
}
__device__ __forceinline__ void t_prep_odd(const Frame& F, const bf16* U, const float* cqg, const float* ckvg, bf16* CQN, bf16* CKVN) {
    const int lane = F.lane;
    for (int m = F.gw; m < M; m += F.NGW) { const bf16* u = U + (size_t)m * C_INP;
        { float v[8]; float s = 0.f; if (lane < 48) { unpack8(*(const v4u*)(u + V_CQ + 8 * lane), v);
#pragma unroll
                for (int e = 0; e < 8; ++e) s += v[e] * v[e]; }
          const float rs = __builtin_amdgcn_rsqf(wave_sum(s) * (1.0f / 384.0f) + EPS);
          if (lane < 48) { const f32x4 g0 = *(const f32x4*)(cqg + 8 * lane), g1 = *(const f32x4*)(cqg + 8 * lane + 4);
              float o[8] = {v[0] * rs * g0[0], v[1] * rs * g0[1], v[2] * rs * g0[2], v[3] * rs * g0[3], v[4] * rs * g1[0], v[5] * rs * g1[1], v[6] * rs * g1[2], v[7] * rs * g1[3]};
              *(v4u*)(CQN + (size_t)m * 384 + 8 * lane) = pack8(o); } }
        { float v[8]; float s = 0.f; if (lane < 32) { unpack8(*(const v4u*)(u + V_CKV + 8 * lane), v);
#pragma unroll
                for (int e = 0; e < 8; ++e) s += v[e] * v[e]; }
          const float rs = __builtin_amdgcn_rsqf(wave_sum(s) * (1.0f / 256.0f) + EPS);
          if (lane < 32) { const f32x4 g0 = *(const f32x4*)(ckvg + 8 * lane), g1 = *(const f32x4*)(ckvg + 8 * lane + 4);
              float o[8] = {v[0] * rs * g0[0], v[1] * rs * g0[1], v[2] * rs * g0[2], v[3] * rs * g0[3], v[4] * rs * g1[0], v[5] * rs * g1[1], v[6] * rs * g1[2], v[7] * rs * g1[3]};
              *(v4u*)(CKVN + (size_t)m * 256 + 8 * lane) = pack8(o); } }
    }
}
__device__ __forceinline__ unsigned fkey(float f) { const unsigned u = __float_as_uint(f); return (u & 0x80000000u) ? ~u : (u | 0x80000000u); }
__device__ __forceinline__ void topk_bitmap(const LAS float* row, int t, unsigned* bmrow, int lane) {
    unsigned u[32];
#pragma unroll
    for (int i = 0; i < 32; ++i) u[i] = (lane <= t - 64 * i) ? fkey(row[lane + 64 * i]) : 0u;
    unsigned tau = 0u;
#pragma unroll 1
    for (int bit = 31; bit >= 0; --bit) { const unsigned cand = tau | (1u << bit); int cnt = 0;
#pragma unroll
        for (int i = 0; i < 32; ++i) cnt += __popcll(__ballot(u[i] >= cand));
        if (cnt >= 256) tau = cand; }
    int cgt = 0;
#pragma unroll
    for (int i = 0; i < 32; ++i) cgt += __popcll(__ballot(u[i] > tau));
    int rem = 256 - cgt; unsigned myword = 0u;
#pragma unroll
    for (int i = 0; i < 32; ++i) { const unsigned long long gt = __ballot(u[i] > tau), eq = __ballot(u[i] == tau); const int pc = __popcll(eq); unsigned long long sel;
        if (pc <= rem) { sel = eq; rem -= pc; }
        else { const int rank = __popcll(eq & ((1ull << lane) - 1ull)); sel = __ballot(u[i] == tau && rank < rem); rem = 0; }
        const unsigned long long w = gt | sel;
        { const unsigned wlo = (unsigned)__builtin_amdgcn_readfirstlane((int)(unsigned)w), whi = (unsigned)__builtin_amdgcn_readfirstlane((int)(unsigned)(w >> 32));
          asm volatile("v_writelane_b32 %0, %1, %2" : "+v"(myword) : "s"(wlo), "i"(2 * i));
          asm volatile("v_writelane_b32 %0, %1, %2" : "+v"(myword) : "s"(whi), "i"(2 * i + 1)); } }
    bmrow[lane] = myword;
}
__device__ __forceinline__ void ph_indexer_simple(const Frame& F, const bf16* U, unsigned* BM) {
    const int lane = F.lane; LAS float* qs = (LAS float*)(F.lds + F.wave * 12288); LAS float* sc = qs + 512;
    for (int m = F.gw; m < M; m += F.NGW) { const int t = m & (SEQ - 1), kb = m - t; unsigned* bmrow = BM + (size_t)m * 64;
        if (t < 256) { const int n = t + 1 - 32 * lane; bmrow[lane] = n >= 32 ? 0xffffffffu : (n > 0 ? ((1u << n) - 1u) : 0u); continue; }
        const bf16* u = U + (size_t)m * C_INP;
        { float v[8]; unpack8(*(const v4u*)(u + V_QI + 8 * lane), v);
#pragma unroll
          for (int e = 0; e < 8; ++e) qs[8 * lane + e] = v[e]; }
        float wi[8]; { float v[8]; unpack8(*(const v4u*)(u + V_WI), v);
#pragma unroll
          for (int e = 0; e < 8; ++e) wi[e] = v[e]; }
        LDS_WAIT(); asm volatile("" ::: "memory");
        for (int j0 = 0; j0 <= t; j0 += 64) { const int j = j0 + lane; const bool valid = j <= t;
            const bf16* kr = U + (size_t)(kb + (valid ? j : t)) * C_INP + V_KI;
            float d[8];
#pragma unroll
            for (int h = 0; h < 8; ++h) d[h] = 0.f;
#pragma unroll 1
            for (int c = 0; c < 8; ++c) { asm volatile("" ::: "memory"); float v[8]; unpack8(*(const v4u*)(kr + 8 * c), v);
#pragma unroll
                for (int h = 0; h < 8; ++h) { const f32x4 q0 = *(const LAS f32x4*)(qs + h * 64 + 8 * c), q1 = *(const LAS f32x4*)(qs + h * 64 + 8 * c + 4);
                    d[h] += q0[0] * v[0] + q0[1] * v[1] + q0[2] * v[2] + q0[3] * v[3] + q1[0] * v[4] + q1[1] * v[5] + q1[2] * v[6] + q1[3] * v[7]; } }
            float acc = 0.f;
#pragma unroll
            for (int h = 0; h < 8; ++h) acc += fmaxf(d[h], 0.f) * wi[h];
            sc[j] = valid ? acc : -__builtin_inff(); }
        LDS_WAIT(); asm volatile("" ::: "memory");
        topk_bitmap(sc, t, bmrow, lane);
        LDS_WAIT(); asm volatile("" ::: "memory");
    }
}

struct AttnBufs { const bf16 *qa_, *kva_, *kr_, *qkm_, *u_, *qd_, *kvd_, *qx_, *kvx_; const float* fg_; const unsigned* bm_; bf16 *mix_, *hm_, *ox_; };
template <int MODE>
__device__ __forceinline__ void attn_task(const AttnBufs& A, int m, int h, LAS float* qs, int lane) {
    constexpr int DK = (MODE == 0) ? 192 : 128;
    const int b = m >> 11, t = m & (SEQ - 1), kb = m - t;
    const bf16* qrow = MODE == 0 ? A.qa_ + (size_t)m * 768 + h * 192 : MODE == 1 ? A.qkm_ + (size_t)m * 1024 + h * 128 : MODE == 2 ? A.qd_ + (size_t)m * 1024 + h * 128 : A.qx_ + (size_t)m * 512 + h * 128;
    for (int d = lane; d < DK; d += 64) qs[d] = bf2f(qrow[d]);
    LDS_WAIT(); asm volatile("" ::: "memory");
    const int nkeys = MODE == 3 ? NMEM : t + 1;
    float mrun = -1e30f, l = 0.f, a0 = 0.f, a1 = 0.f;
    for (int j0 = 0; j0 < nkeys; j0 += 64) { asm volatile("" ::: "memory"); const int j = j0 + lane; bool valid = j < nkeys;
        if (MODE == 2) { const unsigned w = A.bm_[(size_t)m * 64 + (j0 >> 5) + (lane >> 5)]; valid = valid && ((w >> (lane & 31)) & 1u); }
        if (!__any(valid)) continue;
        float dot = 0.f, bias = 0.f;
        if (valid) {
            const size_t kr = MODE == 3 ? (size_t)(b * NMEM + j) : (size_t)(kb + j);
            const bf16* kp = MODE == 0 ? A.kva_ + kr * 1024 + h * 256 : MODE == 1 ? A.qkm_ + kr * 1024 + 512 + h * 128 : MODE == 2 ? A.kvd_ + kr * 2048 + h * 128 : A.kvx_ + kr * 1024 + h * 128;
#pragma unroll
            for (int c = 0; c < 16; ++c) { float v[8]; unpack8(*(const v4u*)(kp + 8 * c), v); const f32x4 q0 = *(const LAS f32x4*)(qs + 8 * c), q1 = *(const LAS f32x4*)(qs + 8 * c + 4);
                dot += q0[0] * v[0] + q0[1] * v[1] + q0[2] * v[2] + q0[3] * v[3] + q1[0] * v[4] + q1[1] * v[5] + q1[2] * v[6] + q1[3] * v[7]; }
            if (MODE == 0) { const bf16* kp2 = A.kr_ + kr * 64;
#pragma unroll
                for (int c = 0; c < 8; ++c) { float v[8]; unpack8(*(const v4u*)(kp2 + 8 * c), v); const f32x4 q0 = *(const LAS f32x4*)(qs + 128 + 8 * c), q1 = *(const LAS f32x4*)(qs + 128 + 8 * c + 4);
                    dot += q0[0] * v[0] + q0[1] * v[1] + q0[2] * v[2] + q0[3] * v[3] + q1[0] * v[4] + q1[1] * v[5] + q1[2] * v[6] + q1[3] * v[7]; } }
            if (MODE == 1) bias = A.fg_[(kr * 4 + h) * 2 + 1];
        }
        const float x = MODE == 1 ? bias : dot;
        const float cm = wave_max(valid ? x : -__builtin_inff());
        const float mn = fmaxf(mrun, cm), alpha = __builtin_amdgcn_exp2f(mrun - mn); mrun = mn;
        float p = valid ? __builtin_amdgcn_exp2f(x - mn) : 0.f; if (MODE == 1) p *= dot;
        l = l * alpha + wave_sum(p); a0 *= alpha; a1 *= alpha;
        const int cnt = (nkeys - j0) < 64 ? (nkeys - j0) : 64;
        const size_t vr0 = MODE == 3 ? (size_t)(b * NMEM + j0) : (size_t)(kb + j0);
        const bf16* vbase = MODE == 0 ? A.kva_ + vr0 * 1024 + h * 256 + 128 : MODE == 1 ? A.u_ + vr0 * AB_INP + U_VM + h * 128 : MODE == 2 ? A.kvd_ + vr0 * 2048 + 1024 + h * 128 : A.kvx_ + vr0 * 1024 + 512 + h * 128;
        constexpr int VLD = MODE == 0 ? 1024 : MODE == 1 ? AB_INP : MODE == 2 ? 2048 : 1024;
        for (int jj = 0; jj < cnt; ++jj) { const float pj = rdlane(p, jj);
            if (pj != 0.f) { const unsigned vv = *(const unsigned*)(vbase + (size_t)jj * VLD + 2 * lane); a0 += pj * bflo(vv); a1 += pj * bfhi(vv); } }
    }
    float inv;
    if (MODE == 1) { const float F2 = A.fg_[((size_t)m * 4 + h) * 2]; inv = 1.0f / fmaxf(fabsf(l), __builtin_amdgcn_exp2f(-(F2 + mrun))); }
    else inv = 1.0f / l;
    bf16* op = MODE == 0 ? A.mix_ + (size_t)m * 1024 + h * 128 : MODE == 1 ? A.hm_ + (size_t)m * 512 + h * 128 : MODE == 2 ? A.mix_ + (size_t)m * 1024 + h * 128 : A.ox_ + (size_t)m * 512 + h * 128;
    *(unsigned*)(op + 2 * lane) = pk2(a0 * inv, a1 * inv);
    LDS_WAIT(); asm volatile("" ::: "memory");
}
template <int MODE, int NH>
__device__ __forceinline__ void ph_attn_simple(const Frame& F, const AttnBufs& A) {
    LAS float* qs = (LAS float*)(F.lds + F.wave * 1024);
    for (int task = F.gw; task < M * NH; task += F.NGW) attn_task<MODE>(A, task / NH, task % NH, qs, F.lane);
}
namespace fa {
typedef short bf16x8 __attribute__((ext_vector_type(8)));
typedef short s16x4 __attribute__((ext_vector_type(4)));
typedef float f32x16 __attribute__((ext_vector_type(16)));
typedef unsigned u32x4 __attribute__((ext_vector_type(4)));
#define FA_KSWZ(row, colB) ((row) * 256 + ((colB) ^ (((row) & 7) << 4)))
#define FA_KSWZ2(row, colB) ((row) * 128 + ((colB) ^ (((row) & 7) << 4)))
#define FA_SBAR() __builtin_amdgcn_sched_barrier(0)
__device__ __forceinline__ int crow(int r, int hi) { return (r & 3) + 8 * (r >> 2) + 4 * hi; }
__device__ __forceinline__ unsigned cvtpk(float lo, float hi) { unsigned r; asm volatile("v_cvt_pk_bf16_f32 %0, %1, %2" : "=v"(r) : "v"(lo), "v"(hi)); return r; }
__device__ __forceinline__ int v_st(int k, int c) { const int kk = (k & ~0xC) | ((k & 4) << 1) | ((k & 8) >> 1); return ((kk >> 3) * 4 + (c >> 5)) * 512 + ((kk & 7) * 32 + (c & 31)) * 2; }
__device__ __forceinline__ int v_rd_base(int lane) { return ((lane & 3) << 3) | (((lane >> 2) & 3) << 6) | (((lane >> 4) & 1) << 5) | (((lane >> 5) & 1) << 8); }
constexpr int v_rd_off(int d0, int ks, int half) { return d0 * 512 + ks * 4096 + half * 2048; }
template <int OFF> __device__ __forceinline__ s16x4 tr_read(int vb) { s16x4 r; asm volatile("ds_read_b64_tr_b16 %0, %1 offset:%2" : "=&v"(r) : "v"(vb), "i"(OFF) : "memory"); return r; }
template <int D0> __device__ __forceinline__ void pv_one(f32x16& od, int vb, bf16x8 pa0, bf16x8 pa1, bf16x8 pa2, bf16x8 pa3) {
    const s16x4 l0 = tr_read<v_rd_off(D0, 0, 0)>(vb), h0 = tr_read<v_rd_off(D0, 0, 1)>(vb), l1 = tr_read<v_rd_off(D0, 1, 0)>(vb), h1 = tr_read<v_rd_off(D0, 1, 1)>(vb);
    const s16x4 l2 = tr_read<v_rd_off(D0, 2, 0)>(vb), h2 = tr_read<v_rd_off(D0, 2, 1)>(vb), l3 = tr_read<v_rd_off(D0, 3, 0)>(vb), h3 = tr_read<v_rd_off(D0, 3, 1)>(vb);
    asm volatile("s_waitcnt lgkmcnt(0)" ::: "memory"); FA_SBAR();
#define FA_PK(L, H) (bf16x8){L[0], L[1], L[2], L[3], H[0], H[1], H[2], H[3]}
    od = __builtin_amdgcn_mfma_f32_32x32x16_bf16(pa0, FA_PK(l0, h0), od, 0, 0, 0);
    od = __builtin_amdgcn_mfma_f32_32x32x16_bf16(pa1, FA_PK(l1, h1), od, 0, 0, 0);
    od = __builtin_amdgcn_mfma_f32_32x32x16_bf16(pa2, FA_PK(l2, h2), od, 0, 0, 0);
    od = __builtin_amdgcn_mfma_f32_32x32x16_bf16(pa3, FA_PK(l3, h3), od, 0, 0, 0);
#undef FA_PK
}
struct Args {
    const bf16* Q; int ldq;
    const bf16* K; int ldk;
    const bf16* K2; int ldk2;
    const bf16* V; int ldv;
    bf16* O; int ldo;
    int nt, diag0;
    const float* fg;
    int q0;
    const unsigned* bm;
};
constexpr float THR2 = 11.0f;
constexpr int LDS_V = 0, LDS_K = 32768, LDS_K2 = 65536, LDS_WS = 81920, LDS_GB = 83968, LDS_END = 84480;
template <int MODE>
__device__ __forceinline__ void unit(const Args& a, LAS unsigned char* lds, const int tid) {
    constexpr int NK = (MODE == 0) ? 12 : 8;
    const int wid = __builtin_amdgcn_readfirstlane(tid >> 6), lane = tid & 63, r32 = lane & 31, hi = lane >> 5;
    LAS unsigned char* V_lds = lds + LDS_V; LAS unsigned char* K_lds = lds + LDS_K; LAS unsigned char* K2_lds = lds + LDS_K2;
    LAS float* wsl = (LAS float*)(lds + LDS_WS) + wid * 64; LAS float* li_l = wsl; LAS float* al_l = wsl + 32; LAS float* gb = (LAS float*)(lds + LDS_GB);
    float m_reg = -1e30f, l_reg = 0.f; f32x16 o[4];
#pragma unroll
    for (int d = 0; d < 4; ++d)
#pragma unroll
        for (int r = 0; r < 16; ++r) o[d][r] = 0.f;
    bf16x8 qr[NK];
    { const bf16* Qw = a.Q + (size_t)(wid * 32 + r32) * a.ldq + hi * 8;
#pragma unroll
      for (int d0 = 0; d0 < NK; ++d0) qr[d0] = *(const bf16x8*)(Qw + d0 * 16); }
    const int sr = tid >> 4, sc = (tid & 15) * 8, vst0 = v_st(sr, sc), vst1 = v_st(32 + sr, sc), k2r = tid >> 3, k2c = (tid & 7) * 8;
    const int vb0 = (int)(unsigned)(size_t)V_lds + v_rd_base(lane);
    bf16x8 sv0, sv1, sk0, sk1, sk2; float sg = 0.f; unsigned bw0 = 0u, bw1 = 0u, nbw0 = 0u, nbw1 = 0u;
#define FA_SLOAD(j) do { const size_t k0_ = (size_t)(j) * 64; \
        sv0 = *(const bf16x8*)(a.V + (k0_ + sr) * a.ldv + sc); sv1 = *(const bf16x8*)(a.V + (k0_ + 32 + sr) * a.ldv + sc); \
        sk0 = *(const bf16x8*)(a.K + (k0_ + sr) * a.ldk + sc); sk1 = *(const bf16x8*)(a.K + (k0_ + 32 + sr) * a.ldk + sc); \
        if (MODE == 0) sk2 = *(const bf16x8*)(a.K2 + (k0_ + k2r) * a.ldk2 + k2c); \
        if (MODE == 1) { if (tid < 64) sg = a.fg[(k0_ + tid) * 8 + 1]; } \
        if (MODE == 2) { const unsigned long long w_ = *(const unsigned long long*)(a.bm + (size_t)(wid * 32 + r32) * 64 + 2 * (j)); nbw0 = (unsigned)w_; nbw1 = (unsigned)(w_ >> 32); } } while (0)
#define FA_SWRITE(b) do { *(LAS bf16x8*)(V_lds + (b) * 16384 + vst0) = sv0; *(LAS bf16x8*)(V_lds + (b) * 16384 + vst1) = sv1; \
        *(LAS bf16x8*)(K_lds + (b) * 16384 + FA_KSWZ(sr, sc * 2)) = sk0; *(LAS bf16x8*)(K_lds + (b) * 16384 + FA_KSWZ(32 + sr, sc * 2)) = sk1; \
        if (MODE == 0) *(LAS bf16x8*)(K2_lds + (b) * 8192 + FA_KSWZ2(k2r, k2c * 2)) = sk2; \
        if (MODE == 1) { if (tid < 64) gb[(b) * 64 + tid] = sg; } } while (0)
    const int NT = a.nt;
    FA_SLOAD(0); FA_SWRITE(0); bw0 = nbw0; bw1 = nbw1;
    __syncthreads();
    for (int j = 0; j < NT; ++j) {
        const int b = j & 1;
        if (j + 1 < NT) FA_SLOAD(j + 1);
        f32x16 p0, p1;
#pragma unroll
        for (int r = 0; r < 16; ++r) { p0[r] = 0.f; p1[r] = 0.f; }
        { const LAS unsigned char* Ks = K_lds + b * 16384;
#pragma unroll
          for (int d0 = 0; d0 < 8; ++d0) { const int cb = (d0 * 16 + hi * 8) * 2;
              const bf16x8 b0 = *(const LAS bf16x8*)(Ks + FA_KSWZ(r32, cb)), b1 = *(const LAS bf16x8*)(Ks + FA_KSWZ(32 + r32, cb));
              p0 = __builtin_amdgcn_mfma_f32_32x32x16_bf16(b0, qr[d0], p0, 0, 0, 0); p1 = __builtin_amdgcn_mfma_f32_32x32x16_bf16(b1, qr[d0], p1, 0, 0, 0); }
          if (MODE == 0) { const LAS unsigned char* K2s = K2_lds + b * 8192;
#pragma unroll
              for (int d0 = 0; d0 < 4; ++d0) { const int cb = (d0 * 16 + hi * 8) * 2;
                  const bf16x8 b0 = *(const LAS bf16x8*)(K2s + FA_KSWZ2(r32, cb)), b1 = *(const LAS bf16x8*)(K2s + FA_KSWZ2(32 + r32, cb));
                  p0 = __builtin_amdgcn_mfma_f32_32x32x16_bf16(b0, qr[(MODE == 0) ? 8 + d0 : 0], p0, 0, 0, 0); p1 = __builtin_amdgcn_mfma_f32_32x32x16_bf16(b1, qr[(MODE == 0) ? 8 + d0 : 0], p1, 0, 0, 0); } } }
        f32x16 x0, x1;
        if (MODE == 1) {
#pragma unroll
            for (int q4 = 0; q4 < 4; ++q4) { const f32x4 g0 = *(const LAS f32x4*)(gb + b * 64 + 8 * q4 + 4 * hi), g1 = *(const LAS f32x4*)(gb + b * 64 + 32 + 8 * q4 + 4 * hi);
#pragma unroll
                for (int e = 0; e < 4; ++e) { x0[4 * q4 + e] = g0[e]; x1[4 * q4 + e] = g1[e]; } }
        } else { x0 = p0; x1 = p1; }
        const float NEG = -__builtin_inff();
        if (MODE == 0 || MODE == 1) { if (j >= a.diag0) { const int dq = wid * 32 + r32 - 64 * (j - a.diag0) - 4 * hi;
#pragma unroll
                for (int r = 0; r < 16; ++r) { const int c = (r & 3) + 8 * (r >> 2); if (c > dq) x0[r] = NEG; if (c + 32 > dq) x1[r] = NEG; } } }
        if (MODE == 2) { const unsigned w0 = bw0 >> (4 * hi), w1 = bw1 >> (4 * hi);
#pragma unroll
            for (int r = 0; r < 16; ++r) { const int c = (r & 3) + 8 * (r >> 2); if (!((w0 >> c) & 1u)) x0[r] = NEG; if (!((w1 >> c) & 1u)) x1[r] = NEG; } }
        float pmax = x0[0];
#pragma unroll
        for (int r = 1; r < 16; ++r) pmax = fmaxf(pmax, x0[r]);
#pragma unroll
        for (int r = 0; r < 16; ++r) pmax = fmaxf(pmax, x1[r]);
        { const auto rr = __builtin_amdgcn_permlane32_swap(__float_as_uint(pmax), __float_as_uint(pmax), false, false); pmax = fmaxf(__uint_as_float(rr[0]), __uint_as_float(rr[1])); }
        float mn, alpha;
        if (__all(pmax - m_reg <= THR2)) { mn = m_reg; alpha = 1.f; }
        else { mn = fmaxf(m_reg, pmax); alpha = __builtin_amdgcn_exp2f(m_reg - mn); m_reg = mn; }
#pragma unroll
        for (int r = 0; r < 16; ++r) { x0[r] = __builtin_amdgcn_exp2f(x0[r] - mn); x1[r] = __builtin_amdgcn_exp2f(x1[r] - mn); }
        if (MODE == 1) {
#pragma unroll
            for (int r = 0; r < 16; ++r) { x0[r] *= p0[r]; x1[r] *= p1[r]; } }
        float ps = 0.f;
#pragma unroll
        for (int r = 0; r < 16; ++r) ps += x0[r] + x1[r];
        { const auto rr = __builtin_amdgcn_permlane32_swap(__float_as_uint(ps), __float_as_uint(ps), false, false); ps = __uint_as_float(rr[0]) + __uint_as_float(rr[1]); }
        l_reg = l_reg * alpha + ps;
        bf16x8 pa0, pa1, pa2, pa3;
#define FA_PK4(P, BASE, OUT) do { const unsigned a0_ = cvtpk(P[BASE + 0], P[BASE + 1]), a1_ = cvtpk(P[BASE + 2], P[BASE + 3]), b0_ = cvtpk(P[BASE + 4], P[BASE + 5]), b1_ = cvtpk(P[BASE + 6], P[BASE + 7]); \
        const auto r0_ = __builtin_amdgcn_permlane32_swap(a0_, b0_, false, false); const auto r1_ = __builtin_amdgcn_permlane32_swap(a1_, b1_, false, false); \
        u32x4 w_ = {r0_[0], r1_[0], r0_[1], r1_[1]}; OUT = *reinterpret_cast<bf16x8*>(&w_); } while (0)
        FA_PK4(x0, 0, pa0); FA_PK4(x0, 8, pa1); FA_PK4(x1, 0, pa2); FA_PK4(x1, 8, pa3);
#undef FA_PK4
        if (__any(alpha < 1.f)) { if (hi == 0) al_l[r32] = alpha; asm volatile("s_waitcnt lgkmcnt(0)" ::: "memory");
#pragma unroll
            for (int q4 = 0; q4 < 4; ++q4) { const f32x4 av = *(const LAS f32x4*)(al_l + 8 * q4 + 4 * hi);
#pragma unroll
                for (int d = 0; d < 4; ++d) { o[d][4 * q4 + 0] *= av[0]; o[d][4 * q4 + 1] *= av[1]; o[d][4 * q4 + 2] *= av[2]; o[d][4 * q4 + 3] *= av[3]; } } }
        { const int vb = vb0 + b * 16384; pv_one<0>(o[0], vb, pa0, pa1, pa2, pa3); pv_one<1>(o[1], vb, pa0, pa1, pa2, pa3); pv_one<2>(o[2], vb, pa0, pa1, pa2, pa3); pv_one<3>(o[3], vb, pa0, pa1, pa2, pa3); }
        if (j + 1 < NT) { FA_SWRITE((j + 1) & 1); bw0 = nbw0; bw1 = nbw1; }
        __syncthreads();
    }
    { float den = l_reg;
      if (MODE == 1) { const float F2 = a.fg[(size_t)(a.q0 + wid * 32 + r32) * 8]; den = fmaxf(fabsf(l_reg), __builtin_amdgcn_exp2f(-(F2 + m_reg))); }
      if (hi == 0) li_l[r32] = __builtin_amdgcn_rcpf(den);
      asm volatile("s_waitcnt lgkmcnt(0)" ::: "memory");
      bf16* Ow = a.O + (size_t)(wid * 32) * a.ldo;
#pragma unroll
      for (int q4 = 0; q4 < 4; ++q4) { const f32x4 rl = *(const LAS f32x4*)(li_l + 8 * q4 + 4 * hi);
#pragma unroll
          for (int e = 0; e < 4; ++e) { const int orow = 8 * q4 + 4 * hi + e;
#pragma unroll
              for (int d = 0; d < 4; ++d) Ow[(size_t)orow * a.ldo + d * 32 + r32] = (bf16)f2bf(o[d][4 * q4 + e] * rl[e]); } } }
    __syncthreads();
#undef FA_SLOAD
#undef FA_SWRITE
}
}
#ifndef FA_MLA
#define FA_MLA 1
#endif
#ifndef FA_MLSTM
#define FA_MLSTM 1
#endif
#ifndef FA_DSA
#define FA_DSA 1
#endif
#ifndef FA_CROSS
#define FA_CROSS 1
#endif
template <class Epi>
__device__ __forceinline__ void run_gemm(const Frame& F, const bf16* A, const bf16* Bt, int Mr, int N, int K, const Epi& E, int crot) {
    pg8::Gemm g{A, Bt, Mr, N, K}; pg8::StaticOrder S; int c = (int)blockIdx.x - crot; if (c < 0) c += F.G; S.init(Mr, N, F.G, c);
    pg8::gemm_phase<Epi, pg8::StaticOrder, true, true>(F.lds, g, S, E, F.wave);
}

typedef const float* cfptr;
__device__ __forceinline__ cfptr inp_ptr(int i) {
    unsigned long long ka = (unsigned long long)__builtin_amdgcn_kernarg_segment_ptr(); asm volatile("" : "+s"(ka));
    const unsigned long long v = ((const __attribute__((address_space(4))) unsigned long long*)ka)[i];
    return (cfptr)(const __attribute__((address_space(1))) float*)v;
}
#define INP(i) inp_ptr(i)
__global__ void __launch_bounds__(NWAVES * 64, 2) mega_fwd(Params P) {
    extern __shared__ __attribute__((aligned(16))) unsigned char lds_raw[];
    const int wave_s = __builtin_amdgcn_readfirstlane((int)threadIdx.x >> 6);
#define MK_FRAME() Frame F; unsigned char* ws = P.ws; asm volatile("" : "+s"(ws)); { int l_o; asm volatile("v_mbcnt_lo_u32_b32 %0, -1, 0\n\tv_mbcnt_hi_u32_b32 %0, -1, %0" : "=v"(l_o)); F.lds = (LAS unsigned char*)lds_raw; F.lane = l_o; F.wave = wave_s; F.tid = wave_s * 64 + l_o; \
    F.G = gridDim.x; F.gw = blockIdx.x * NWAVES + F.wave; F.NGW = F.G * NWAVES; }
    MK_FRAME();
    for (int u = F.tid; u < (LDS_BYTES - LDSCTL_OFF) / 4; u += NWAVES * 64) ((LAS unsigned*)(F.lds + LDSCTL_OFF))[u] = 0u;
    __syncthreads();
    XcdBarrier bar = xcd_barrier_post((unsigned*)(ws + WS_CTL) + CW_BAR, (volatile LAS unsigned*)(F.lds + MISC_OFF) + 8);
    const int lo = P.st_lo, hi = P.st_hi; int step = 0;
#define STEP_BEGIN if (step >= lo && step < hi) { MK_FRAME();
#define STEP_END if (step + 1 < hi) xcd_barrier(bar); } ++step;

#define WGU ((bf16*)(ws + WS_WGU))
#define WDN ((bf16*)(ws + WS_WDN))
#define WXQ ((bf16*)(ws + WS_WXQ))
#define WXKV ((bf16*)(ws + WS_WXKV))
#define WXO ((bf16*)(ws + WS_WXO))
#define WIN ((bf16*)(ws + WS_WIN))
#define WOUT ((bf16*)(ws + WS_WOUT))
#define WUQ ((bf16*)(ws + WS_WUQ))
#define WUKV ((bf16*)(ws + WS_WUKV))
#define WQK ((bf16*)(ws + WS_WQK))
#define WGEFF ((float*)(ws + WS_WGEFF))
#define MEMN ((bf16*)(ws + WS_MEMN))
#define KVX ((bf16*)(ws + WS_KVX))
#define ROPE ((float*)(ws + WS_ROPE))
#define XB ((bf16*)(ws + WS_XB))
#define Y ((bf16*)(ws + WS_Y))
#define ACT ((bf16*)(ws + WS_ACT))
#define U ((bf16*)(ws + WS_U))
#define CQN ((bf16*)(ws + WS_CQN))
#define CKVN ((bf16*)(ws + WS_CKVN))
#define KR ((bf16*)(ws + WS_KR))
#define XC ((bf16*)(ws + WS_XC))
#define GATE ((float*)(ws + WS_GATE))
#define FG ((float*)(ws + WS_FG))
#define QA ((bf16*)(ws + WS_QA))
#define KVA ((bf16*)(ws + WS_KVA))
#define QKM ((bf16*)(ws + WS_QKM))
#define HM ((bf16*)(ws + WS_HM))
#define MIX ((bf16*)(ws + WS_MIX))
#define BM ((unsigned*)(ws + WS_BM))
#define QX ((bf16*)(ws + WS_QX))
#define OX ((bf16*)(ws + WS_OX))
#define X (P.out)
#define MK_AB() AttnBufs AB; AB.qa_ = QA; AB.kva_ = KVA; AB.kr_ = KR; AB.qkm_ = QKM; AB.u_ = U; AB.qd_ = QA; AB.kvd_ = KVA; AB.qx_ = QX; AB.kvx_ = KVX; AB.fg_ = FG; AB.bm_ = BM; AB.mix_ = MIX; AB.hm_ = HM; AB.ox_ = OX;
    STEP_BEGIN
        t_norm(F, INP(I_X), X, nullptr, 0.f, nullptr, INP(I_NORMG), XB);
        t_rope_table(F, (const int*)INP(I_POS), ROPE);
    STEP_END

    for (int it = 0; it < 2 * DEPTH; ++it) {
        const int l = it >> 1, f = it & 1, par = l & 1, e = l >> 1;
        const float* ng = INP(I_NORMG) + (size_t)l * 8 * DM;
        if (f == 0) {
            STEP_BEGIN
                int cur = 0;
                for (int ff = 0; ff < 2; ++ff) { const size_t wo = ((size_t)l * 2 + ff) * DM * FFN;
                    conv_mat(F, cur, INP(I_WG) + wo, DM, FFN, FFN, WGU + (size_t)ff * 5632 * DM, DM, 0, 1.f, MapGU{0});
                    conv_mat(F, cur, INP(I_WU) + wo, DM, FFN, FFN, WGU + (size_t)ff * 5632 * DM, DM, 0, 1.f, MapGU{128});
                    conv_mat(F, cur, INP(I_WD) + wo, FFN, DM, DM, WDN + (size_t)ff * DM * FFN, FFN, 0, 1.f, MapId{0}); }
                conv_mat(F, cur, INP(I_XQ) + (size_t)l * DM * 512, DM, 512, 512, WXQ, DM, 0, 1.f, MapId{0});
                conv_mat(F, cur, INP(I_XK) + (size_t)l * DM * 512, DM, 512, 512, WXKV, DM, 0, 1.f, MapId{0});
                conv_mat(F, cur, INP(I_XV) + (size_t)l * DM * 512, DM, 512, 512, WXKV, DM, 0, 1.f, MapId{512});
                conv_mat(F, cur, INP(I_XO) + (size_t)l * 512 * DM, 512, DM, DM, WXO, 512, 0, 1.f, MapId{0});
                t_memn(F, INP(I_MEM), INP(I_MEMG) + (size_t)l * DM, MEMN);
                if (par == 0) {
                    conv_mat(F, cur, INP(I_ABIN) + (size_t)e * DM * AB_IN, DM, AB_IN, AB_IN, WIN, DM, 0, 1.f, MapId{0});
                    zero_bytes(F, WIN + (size_t)AB_IN * DM, (size_t)(AB_INP - AB_IN) * DM * 2);
                    conv_mat(F, cur, INP(I_ABOUT) + (size_t)e * DM * DM, DM, DM, DM, WOUT, DM, 0, 1.f, MapId{0});
                    conv_mat(F, cur, INP(I_AUQ) + (size_t)e * 384 * 768, 384, 768, 768, WUQ, 384, 0, 1.f, MapRopeQ{});
                    conv_mat(F, cur, INP(I_AUKV) + (size_t)e * 256 * 1024, 256, 1024, 1024, WUKV, 256, 0, 1.f, MapId{0});
                    for (int h = 0; h < 4; ++h) {
                        conv_mat(F, cur, INP(I_MLWQ) + ((size_t)e * 4 + h) * 128 * 128, 128, 128, 128, WQK, 512, h * 128, 1.f, MapId{h * 128});
                        conv_mat(F, cur, INP(I_MLWK) + ((size_t)e * 4 + h) * 128 * 128, 128, 128, 128, WQK, 512, h * 128, 0.08838834764831845f, MapId{512 + h * 128}); }
                    for (int idx = blockIdx.x * 512 + F.tid; idx < 1024 * 48; idx += F.G * 512) { const int row = idx / 48, ch = idx % 48, hh = (row & 511) >> 7; int col = ch * 8; if (col >= hh * 128) col += 128;
                        unsigned zz = 0u; asm volatile("" : "+v"(zz)); *(v4u*)(WQK + (size_t)row * 512 + col) = (v4u){zz, zz, zz, zz}; }
                    t_weff(F, INP(I_MLWQ) + (size_t)e * 4 * 128 * 128, INP(I_MLWK) + (size_t)e * 4 * 128 * 128, INP(I_WGATES) + (size_t)e * 1536 * 8, WGEFF);
                } else {
                    conv_mat(F, cur, INP(I_CIN) + (size_t)e * DM * C_IN, DM, C_IN, C_IN, WIN, DM, 0, 1.f, MapId{0});
                    zero_bytes(F, WIN + (size_t)1248 * DM, (size_t)(C_INP - 1248) * DM * 2);
                    conv_mat(F, cur, INP(I_COUT) + (size_t)e * DM * DM, DM, DM, DM, WOUT, DM, 0, 1.f, MapId{0});
                    conv_mat(F, cur, INP(I_CUQ) + (size_t)e * 384 * 1024, 384, 1024, 1024, WUQ, 384, 0, 1.f, MapId{0});
                    for (int h = 0; h < 8; ++h) {
                        conv_mat(F, cur, INP(I_CUK) + ((size_t)e * 8 + h) * 256 * 128, 256, 128, 128, WUKV, 256, 0, 1.f, MapId{h * 128});
                        conv_mat(F, cur, INP(I_CUV) + ((size_t)e * 8 + h) * 256 * 128, 256, 128, 128, WUKV, 256, 0, 1.f, MapId{1024 + h * 128}); }
                }
            STEP_END
        }
        STEP_BEGIN
            run_gemm(F, XB, WGU + (size_t)f * 5632 * DM, M, 5632, DM, pg8::EpiSwiglu{ACT, FFN}, 0);
            if (f == 0) run_gemm(F, MEMN, WXKV, MROWS, 1024, DM, pg8::EpiPlain{KVX, 1024, 1.f}, 128);
        STEP_END
        STEP_BEGIN
            run_gemm(F, ACT, WDN + (size_t)f * DM * FFN, M, DM, FFN, pg8::EpiPlain{Y, DM, 1.f}, 0);
        STEP_END
        STEP_BEGIN
            const float* gpost = ng + (f == 0 ? 1 : 7) * DM;
            const float* gpre = f == 0 ? ng + 2 * DM : (l + 1 < DEPTH ? ng + 8 * DM : nullptr);
            t_norm(F, X, X, Y, 0.5f, gpost, gpre, XB);
        STEP_END
        if (f == 0) {
            STEP_BEGIN
                if (par == 0) run_gemm(F, XB, WIN, M, AB_INP, DM, pg8::EpiPlain{U, AB_INP, 1.f}, 0);
                else run_gemm(F, XB, WIN, M, C_INP, DM, pg8::EpiPlain{U, C_INP, 1.f}, 0);
            STEP_END
            STEP_BEGIN
                if (par == 0) t_prep_even(F, U, INP(I_ACQG) + (size_t)e * 384, INP(I_ACKVG) + (size_t)e * 256, ROPE, INP(I_CONVW) + (size_t)e * 4 * 512, INP(I_CONVB) + (size_t)e * 512,
                                          WGEFF, INP(I_BGATES) + (size_t)e * 8, CQN, CKVN, KR, XC, GATE);
                else t_prep_odd(F, U, INP(I_CCQG) + (size_t)e * 384, INP(I_CCKVG) + (size_t)e * 256, CQN, CKVN);
            STEP_END
            STEP_BEGIN
                if (par == 0) {
                    if (blockIdx.x < 32 && F.wave == 0) t_scan(F, GATE, FG, (int)blockIdx.x);
                    run_gemm(F, CQN, WUQ, M, 768, 384, pg8::EpiRopeQ{QA, 768, 0.07216878364870323f * LOG2E, ROPE}, 0);
                    run_gemm(F, CKVN, WUKV, M, 1024, 256, pg8::EpiPlain{KVA, 1024, 1.f}, 0);
                    run_gemm(F, XC, WQK, M, 1024, 512, pg8::EpiPlain{QKM, 1024, 1.f}, 0);
                } else {
                    run_gemm(F, CQN, WUQ, M, 1024, 384, pg8::EpiPlain{QA, 1024, 0.08838834764831845f * LOG2E}, 0);
                    run_gemm(F, CKVN, WUKV, M, 2048, 256, pg8::EpiPlain{KVA, 2048, 1.f}, 0);
                }
            STEP_END
            if (par == 1) {
                STEP_BEGIN
                    ph_indexer_simple(F, U, BM);
                STEP_END
            }
            STEP_BEGIN
                MK_AB(); const int vcu = (F.G % 8 == 0) ? ((int)blockIdx.x % 8) * (F.G / 8) + (int)blockIdx.x / 8 : (int)blockIdx.x;
                if (par == 0) {
#if FA_MLA
                    for (int u = vcu; u < 256; u += F.G) { const int bh = u >> 3, qb = u & 7, b = bh >> 2, h = bh & 3; const size_t kb = (size_t)b * SEQ, m0 = kb + 256 * qb;
                        fa::Args a; a.Q = QA + m0 * 768 + h * 192; a.ldq = 768; a.K = KVA + kb * 1024 + h * 256; a.ldk = 1024; a.K2 = KR + kb * 64; a.ldk2 = 64; a.V = KVA + kb * 1024 + h * 256 + 128; a.ldv = 1024;
                        a.O = MIX + m0 * 1024 + h * 128; a.ldo = 1024; a.nt = 4 * (qb + 1); a.diag0 = 4 * qb; a.fg = nullptr; a.q0 = 0; a.bm = nullptr;
                        fa::unit<0>(a, F.lds, F.tid); }
#else
                    ph_attn_simple<0, 4>(F, AB);
#endif
#if FA_MLSTM
                    for (int u = vcu; u < 256; u += F.G) { const int bh = u >> 3, qb = 7 - (u & 7), b = bh >> 2, h = bh & 3; const size_t kb = (size_t)b * SEQ, m0 = kb + 256 * qb;
                        fa::Args a; a.Q = QKM + m0 * 1024 + h * 128; a.ldq = 1024; a.K = QKM + kb * 1024 + 512 + h * 128; a.ldk = 1024; a.K2 = nullptr; a.ldk2 = 0; a.V = U + kb * AB_INP + U_VM + h * 128; a.ldv = AB_INP;
                        a.O = HM + m0 * 512 + h * 128; a.ldo = 512; a.nt = 4 * (qb + 1); a.diag0 = 4 * qb; a.fg = FG + kb * 8 + h * 2; a.q0 = 256 * qb; a.bm = nullptr;
                        fa::unit<1>(a, F.lds, F.tid); }
#else
                    ph_attn_simple<1, 4>(F, AB);
#endif
                } else {
#if FA_DSA
                    for (int u = vcu; u < 256; u += F.G) { const int bh = u >> 2, pi = u & 3, b = bh >> 3, h = bh & 7; const size_t kb = (size_t)b * SEQ;
                        for (int s2 = 0; s2 < 2; ++s2) { const int qb = s2 ? 7 - pi : pi; const size_t m0 = kb + 256 * qb;
                            fa::Args a; a.Q = QA + m0 * 1024 + h * 128; a.ldq = 1024; a.K = KVA + kb * 2048 + h * 128; a.ldk = 2048; a.K2 = nullptr; a.ldk2 = 0; a.V = KVA + kb * 2048 + 1024 + h * 128; a.ldv = 2048;
                            a.O = MIX + m0 * 1024 + h * 128; a.ldo = 1024; a.nt = 4 * (qb + 1); a.diag0 = 4 * qb; a.fg = nullptr; a.q0 = 0; a.bm = BM + m0 * 64;
                            fa::unit<2>(a, F.lds, F.tid); } }
#else
                    ph_attn_simple<2, 8>(F, AB);
#endif
                }
            STEP_END
            if (par == 0) {
                STEP_BEGIN
                    t_mix(F, HM, XC, U, INP(I_GNG) + (size_t)e * 512, INP(I_SKIP) + (size_t)e * 512, MIX);
                STEP_END
            }
            STEP_BEGIN
                run_gemm(F, MIX, WOUT, M, DM, DM, pg8::EpiPlain{Y, DM, 1.f}, 0);
            STEP_END
            STEP_BEGIN
                t_norm(F, X, X, Y, 1.0f, ng + 3 * DM, ng + 4 * DM, XB);
            STEP_END
            STEP_BEGIN
                run_gemm(F, XB, WXQ, M, 512, DM, pg8::EpiPlain{QX, 512, 0.08838834764831845f * LOG2E}, 0);
            STEP_END
            STEP_BEGIN
#if FA_CROSS
                const int vcu = (F.G % 8 == 0) ? ((int)blockIdx.x % 8) * (F.G / 8) + (int)blockIdx.x / 8 : (int)blockIdx.x;
                for (int u = vcu; u < 256; u += F.G) { const int bh = u >> 3, qb = u & 7, b = bh >> 2, h = bh & 3; const size_t m0 = (size_t)b * SEQ + 256 * qb, kr0 = (size_t)b * NMEM;
                    fa::Args a; a.Q = QX + m0 * 512 + h * 128; a.ldq = 512; a.K = KVX + kr0 * 1024 + h * 128; a.ldk = 1024; a.K2 = nullptr; a.ldk2 = 0; a.V = KVX + kr0 * 1024 + 512 + h * 128; a.ldv = 1024;
                    a.O = OX + m0 * 512 + h * 128; a.ldo = 512; a.nt = 4; a.diag0 = 1 << 20; a.fg = nullptr; a.q0 = 0; a.bm = nullptr;
                    fa::unit<3>(a, F.lds, F.tid); }
#else
                MK_AB(); ph_attn_simple<3, 4>(F, AB);
#endif
            STEP_END
            STEP_BEGIN
                run_gemm(F, OX, WXO, M, DM, 512, pg8::EpiPlain{Y, DM, 1.f}, 0);
            STEP_END
            STEP_BEGIN
                t_norm(F, X, X, Y, 1.0f, ng + 5 * DM, ng + 6 * DM, XB);
            STEP_END
        }
    }
#undef STEP_BEGIN
#undef STEP_END
}

#ifndef MK_SPLIT
#define MK_SPLIT 0
#endif
constexpr int N_STEPS = 1 + DEPTH * (1 + 3 + 3 + 1 + 1 + 2 + 4 + 3) - 2;
extern "C" void kernel_launch(void* const* d_in, const int* in_sizes, int n_in, void* d_out, int out_size, void* d_ws, size_t ws_size, hipStream_t stream) {
    static int grid = 0;
    if (grid == 0) {
        if (n_in != 33 || in_sizes[0] != M * DM || out_size != M * DM || ws_size < WS_END) { fprintf(stderr, "kernel_launch: unexpected shapes (n_in %d, in0 %d, out %d, ws %zu < %zu)\n", n_in, n_in > 0 ? in_sizes[0] : -1, out_size, ws_size, (size_t)WS_END); grid = -1; return; }
        int dev = 0, cus = 0;
        if (hipGetDevice(&dev) != hipSuccess || hipDeviceGetAttribute(&cus, hipDeviceAttributeMultiprocessorCount, dev) != hipSuccess) { grid = -1; return; }
        if (hipFuncSetAttribute((const void*)mega_fwd, hipFuncAttributeMaxDynamicSharedMemorySize, LDS_BYTES) != hipSuccess) { fprintf(stderr, "kernel_launch: hipFuncSetAttribute failed\n"); grid = -1; return; }
        int per_cu = 0;
        if (hipOccupancyMaxActiveBlocksPerMultiprocessor(&per_cu, (const void*)mega_fwd, NWAVES * 64, LDS_BYTES) != hipSuccess || per_cu < 1) fprintf(stderr, "kernel_launch: occupancy query says %d\n", per_cu);
        (void)hipGetLastError();
        grid = cus;
    }
    if (grid < 0) return;
    Params p{};
    for (int i = 0; i < 33; ++i) p.in[i] = (const float*)d_in[i];
    p.out = (float*)d_out; p.ws = (unsigned char*)d_ws;
#if MK_SPLIT
    for (int s = 0; s < 200; ++s) { (void)hipMemsetAsync((char*)d_ws + WS_CTL, 0, CTL_BYTES, stream); p.st_lo = s; p.st_hi = s + 1; hipLaunchKernelGGL(mega_fwd, dim3(grid), dim3(NWAVES * 64), LDS_BYTES, stream, p); if (s + 1 >= N_STEPS) break; }
#else
    (void)hipMemsetAsync((char*)d_ws + WS_CTL, 0, CTL_BYTES, stream);
    p.st_lo = 0; p.st_hi = 1 << 20;
    hipLaunchKernelGGL(mega_fwd, dim3(grid), dim3(NWAVES * 64), LDS_BYTES, stream, p);
#endif
    const hipError_t le = hipPeekAtLastError();
    if (le != hipSuccess) fprintf(stderr, "kernel_launch: launch failed: %s\n", hipGetErrorName(le));
}
```

```cpp
#include <hip/hip_runtime.h>
#include <cstdio>
#include <cstdint>
namespace pg8 {
#define PG8_LAS __attribute__((address_space(3)))
typedef unsigned short bf16_t;
typedef short bf16x8 __attribute__((ext_vector_type(8)));
typedef float f32x4 __attribute__((ext_vector_type(4)));
typedef unsigned u32x4 __attribute__((ext_vector_type(4)));
constexpr int BM = 256, BK = 64, HALF = 128, HTB = HALF * BK * 2  , STAGE_BYTES = 8 * HTB, NXCD = 8, WGM = 8;

__host__ __device__ __forceinline__ int lds_byte(int r, int c) { const int st = (r >> 4) * 2 + (c >> 5), rr = r & 15, cc = c & 31, ob = rr * 64 + cc * 2; return st * 1024 + (ob ^ (((ob >> 9) & 1) << 5)); }
__host__ __device__ __forceinline__ void stage_rc(int b, int& R, int& C) { const int st = b / 1024, sb = b % 1024, swz = sb ^ (((sb >> 9) & 1) << 5); R = (st >> 1) * 16 + swz / 64; C = (st & 1) * 32 + (swz % 64) / 2; }
__host__ __device__ __forceinline__ int perm32(int rho) { const int n = rho >> 4, i = rho & 15; return 8 * (i >> 2) + 4 * n + (i & 3); }

struct Unit { int pm, pn; };
struct Gemm { const bf16_t* A; const bf16_t* Bt; int M, N, K; };

struct StaticOrder {
    int nM, nN, nwg, G, c;
    __host__ __device__ void init(int M, int N, int G_, int c_) { nM = M / BM; nN = N / BM; nwg = nM * nN; G = G_; c = c_; }
    __host__ __device__ bool next(int i, Unit& u) const {
        const long L = (long)i * G + c; if (L >= nwg) return false;
        int wgid = (int)L; { const int q = nwg / NXCD, r = nwg % NXCD, xcd = wgid % NXCD, off = wgid / NXCD; wgid = (xcd < r ? xcd * (q + 1) : r * (q + 1) + (xcd - r) * q) + off; }
        const int nig = WGM * nN, gid = wgid / nig, fm = gid * WGM, gsz = (nM - fm) < WGM ? (nM - fm) : WGM;
        u.pm = fm + ((wgid % nig) % gsz); u.pn = (wgid % nig) / gsz; return true;
    }
    __device__ __forceinline__ void a_ready(const Unit&) const {}
    __device__ __forceinline__ void done(const Unit&) const {}
};
__device__ __forceinline__ unsigned cvt_pk_bf16(float lo, float hi) { unsigned r; asm volatile("v_cvt_pk_bf16_f32 %0, %1, %2" : "=v"(r) : "v"(lo), "v"(hi)); return r; }
typedef float f32x2 __attribute__((ext_vector_type(2)));
typedef float f32x2 __attribute__((ext_vector_type(2)));
struct EpiPlain {
    static constexpr bool PERM = true, AFTER_DRAIN = false;
    bf16_t* O; int ldc; float scale;
    __device__ __forceinline__ void operator()(const f32x4 (&acc)[2][2][4][2], const Unit& u, int wr, int wc, int fr_, int fq_) const {
        int ln_; asm volatile("v_mbcnt_lo_u32_b32 %0, -1, 0\n\tv_mbcnt_hi_u32_b32 %0, -1, %0" : "=v"(ln_)); const int fr = ln_ & 15, fq = ln_ >> 4;
        const int row0 = u.pm * BM + wr * 64 + fr, col0 = u.pn * BM + wc * 32 + 8 * fq;
#pragma unroll
        for (int ai = 0; ai < 2; ++ai)
#pragma unroll
            for (int m = 0; m < 4; ++m) { bf16_t* rowp = O + (size_t)(row0 + ai * HALF + m * 16) * ldc + col0;
#pragma unroll
                for (int bj = 0; bj < 2; ++bj) { const f32x4 v0 = acc[ai][bj][m][0] * scale, v1 = acc[ai][bj][m][1] * scale;
                    u32x4 w; w.x = cvt_pk_bf16(v0[0], v0[1]); w.y = cvt_pk_bf16(v0[2], v0[3]); w.z = cvt_pk_bf16(v1[0], v1[1]); w.w = cvt_pk_bf16(v1[2], v1[3]);
                    *(u32x4*)(rowp + bj * HALF) = w; } }
    }
};
__device__ __forceinline__ float silu_mul(float g, float u) { return g * u * __builtin_amdgcn_rcpf(1.0f + __builtin_amdgcn_exp2f(-1.4426950408889634f * g)); }
struct EpiSwiglu {
    static constexpr bool PERM = true, AFTER_DRAIN = false;
    bf16_t* O; int ldc;
    __device__ __forceinline__ void operator()(const f32x4 (&acc)[2][2][4][2], const Unit& u, int wr, int wc, int fr_, int fq_) const {
        int ln_; asm volatile("v_mbcnt_lo_u32_b32 %0, -1, 0\n\tv_mbcnt_hi_u32_b32 %0, -1, %0" : "=v"(ln_)); const int fr = ln_ & 15, fq = ln_ >> 4;
        const int row0 = u.pm * BM + wr * 64 + fr, col0 = u.pn * HALF + wc * 32 + 8 * fq;
#pragma unroll
        for (int ai = 0; ai < 2; ++ai)
#pragma unroll
            for (int m = 0; m < 4; ++m) { bf16_t* rowp = O + (size_t)(row0 + ai * HALF + m * 16) * ldc + col0;
                const f32x4 g0 = acc[ai][0][m][0], g1 = acc[ai][0][m][1], u0 = acc[ai][1][m][0], u1 = acc[ai][1][m][1];
                u32x4 w; w.x = cvt_pk_bf16(silu_mul(g0[0], u0[0]), silu_mul(g0[1], u0[1])); w.y = cvt_pk_bf16(silu_mul(g0[2], u0[2]), silu_mul(g0[3], u0[3]));
                w.z = cvt_pk_bf16(silu_mul(g1[0], u1[0]), silu_mul(g1[1], u1[1])); w.w = cvt_pk_bf16(silu_mul(g1[2], u1[2]), silu_mul(g1[3], u1[3]));
                *(u32x4*)rowp = w; }
    }
};
struct EpiRopeQ {
    static constexpr bool PERM = true, AFTER_DRAIN = false;
    bf16_t* O; int ldc; float scale; const float* rope;
    __device__ __forceinline__ void operator()(const f32x4 (&acc)[2][2][4][2], const Unit& u, int wr, int wc, int fr_, int fq_) const {
        int ln_; asm volatile("v_mbcnt_lo_u32_b32 %0, -1, 0\n\tv_mbcnt_hi_u32_b32 %0, -1, %0" : "=v"(ln_)); const int fr = ln_ & 15, fq = ln_ >> 4;
        const int row0 = u.pm * BM + wr * 64 + fr, col0 = u.pn * BM + wc * 32 + 8 * fq;
#pragma unroll
        for (int ai = 0; ai < 2; ++ai)
#pragma unroll
            for (int m = 0; m < 4; ++m) { const int row = row0 + ai * HALF + m * 16; bf16_t* rowp = O + (size_t)row * ldc + col0;
#pragma unroll
                for (int bj = 0; bj < 2; ++bj) { f32x4 v0 = acc[ai][bj][m][0] * scale, v1 = acc[ai][bj][m][1] * scale;
                    const int w192 = (col0 + bj * HALF) % 192;
                    if (w192 >= 128) { const float* cs = rope + ((size_t)row * 32 + ((w192 - 128) >> 1)) * 2; const f32x4 c0 = *(const f32x4*)cs, c1 = *(const f32x4*)(cs + 4);
                        const f32x4 r0 = {v0[0] * c0[0] - v0[1] * c0[1], v0[0] * c0[1] + v0[1] * c0[0], v0[2] * c0[2] - v0[3] * c0[3], v0[2] * c0[3] + v0[3] * c0[2]};
                        const f32x4 r1 = {v1[0] * c1[0] - v1[1] * c1[1], v1[0] * c1[1] + v1[1] * c1[0], v1[2] * c1[2] - v1[3] * c1[3], v1[2] * c1[3] + v1[3] * c1[2]};
                        v0 = r0; v1 = r1; }
                    u32x4 w; w.x = cvt_pk_bf16(v0[0], v0[1]); w.y = cvt_pk_bf16(v0[2], v0[3]); w.z = cvt_pk_bf16(v1[0], v1[1]); w.w = cvt_pk_bf16(v1[2], v1[3]);
                    *(u32x4*)(rowp + bj * HALF) = w; } }
    }
};
template <class Epi, class Sched, bool ALIGN_EPI = false, bool SP2 = false>
__device__ __forceinline__ void gemm_phase(PG8_LAS unsigned char* lds, const Gemm g, const Sched& S, const Epi& E, const int wave_in) {
    int tid_o; asm volatile("v_mbcnt_lo_u32_b32 %0, -1, 0\n\tv_mbcnt_hi_u32_b32 %0, -1, %0" : "=v"(tid_o)); tid_o += 64 * wave_in; const int tid = tid_o, wid = __builtin_amdgcn_readfirstlane(tid >> 6), lane = tid & 63, wr = wid >> 2, wc = wid & 3, fr = lane & 15, fq = lane >> 4;
    const int K = g.K, nt = K / BK;
    unsigned voffA[2], voffB[2];
#pragma unroll
    for (int i = 0; i < 2; ++i) { int R, C; stage_rc(tid * 16 + i * 8192, R, C); const int Rb = Epi::PERM ? ((R & ~31) + perm32(R & 31)) : R;
        voffA[i] = (unsigned)(R * K + C) * 2u; voffB[i] = (unsigned)(Rb * K + C) * 2u; }
    const size_t kstep = (size_t)(BK * 2);
    const size_t hstep = (size_t)HALF * K * 2;
    const size_t tstep = 2 * hstep;
    const unsigned ldsw = (unsigned)wid * 1024u;
    const int aoff = lds_byte(wr * 64 + fr, fq * 8), boff = lds_byte(wc * 32 + fr, fq * 8);
#define PG8_SA(b, h) (((b) * 2 + (h)) * HTB)
#define PG8_SB(b, h) ((4 + (b) * 2 + (h)) * HTB)
#define PG8_STAGE(bufoff, gbase, voff) do { _Pragma("unroll") for (int _i = 0; _i < 2; ++_i) \
        __builtin_amdgcn_global_load_lds((const unsigned*)((const char*)(gbase) + (voff)[_i]), (PG8_LAS unsigned*)(lds + (bufoff) + ldsw + _i * 8192), 16, 0, 0); } while (0)
#define PG8_LDA(dst, b, h) do { _Pragma("unroll") for (int m = 0; m < 4; ++m) _Pragma("unroll") for (int k = 0; k < 2; ++k) dst[m][k] = *(const PG8_LAS bf16x8*)(lds + PG8_SA(b, h) + aoff + m * 2048 + k * 1024); } while (0)
#define PG8_LDB(dst, b, h) do { _Pragma("unroll") for (int n = 0; n < 2; ++n) _Pragma("unroll") for (int k = 0; k < 2; ++k) dst[n][k] = *(const PG8_LAS bf16x8*)(lds + PG8_SB(b, h) + boff + n * 2048 + k * 1024); } while (0)
#define PG8_MMA(ai, bj, At, Bt) do { __builtin_amdgcn_s_setprio(1); _Pragma("unroll") for (int m = 0; m < 4; ++m) _Pragma("unroll") for (int n = 0; n < 2; ++n) _Pragma("unroll") for (int k = 0; k < 2; ++k) \
        acc[ai][bj][m][n] = __builtin_amdgcn_mfma_f32_16x16x32_bf16(Bt[n][k], At[m][k], acc[ai][bj][m][n], 0, 0, 0); __builtin_amdgcn_s_setprio(0); } while (0)
#define PG8_WAIT_V(n) asm volatile("s_waitcnt vmcnt(" #n ")" ::: "memory")
#define PG8_WAIT_L(n) asm volatile("s_waitcnt lgkmcnt(" #n ")" ::: "memory")
#define PG8_BAR __builtin_amdgcn_s_barrier()
#define PG8_SCHED __builtin_amdgcn_sched_barrier(0)
    Unit cur, nxt; int ui = 0;
    if (!S.next(0, cur)) return;
    f32x4 acc[2][2][4][2];
#pragma unroll
    for (int a = 0; a < 2; ++a)
#pragma unroll
        for (int b = 0; b < 2; ++b)
#pragma unroll
            for (int m = 0; m < 4; ++m)
#pragma unroll
                for (int n = 0; n < 2; ++n) acc[a][b][m][n] = (f32x4){0.f, 0.f, 0.f, 0.f};
    bf16x8 At[4][2], B0[2][2], B1[2][2];
    const char* cA = (const char*)g.A + (size_t)cur.pm * tstep; const char* cB = (const char*)g.Bt + (size_t)cur.pn * tstep;
    S.a_ready(cur);
    if constexpr (SP2) {
        PG8_STAGE(PG8_SB(0, 0), cB, voffB); PG8_STAGE(PG8_SB(0, 1), cB + hstep, voffB); PG8_STAGE(PG8_SA(0, 0), cA, voffA); PG8_STAGE(PG8_SA(0, 1), cA + hstep, voffA);
        if (wr == 1) PG8_BAR;
        PG8_WAIT_V(2); PG8_BAR;
        PG8_STAGE(PG8_SB(1, 0), cB + kstep, voffB); PG8_STAGE(PG8_SA(1, 0), cA + kstep, voffA); PG8_STAGE(PG8_SB(1, 1), cB + hstep + kstep, voffB);
        PG8_WAIT_V(6); PG8_BAR;
    } else {
        PG8_STAGE(PG8_SB(0, 0), cB, voffB); PG8_STAGE(PG8_SA(0, 0), cA, voffA); PG8_STAGE(PG8_SB(0, 1), cB + hstep, voffB); PG8_STAGE(PG8_SA(0, 1), cA + hstep, voffA);
        if (wr == 1) PG8_BAR;
        PG8_WAIT_V(4); PG8_BAR;
        PG8_STAGE(PG8_SB(1, 0), cB + kstep, voffB); PG8_STAGE(PG8_SA(1, 0), cA + kstep, voffA); PG8_STAGE(PG8_SB(1, 1), cB + hstep + kstep, voffB);
        PG8_WAIT_V(6); PG8_BAR;
    }
    for (;;) {
        const bool has_next = S.next(ui + 1, nxt);
        const char* nA = has_next ? (const char*)g.A + (size_t)nxt.pm * tstep : cA; const char* nB = has_next ? (const char*)g.Bt + (size_t)nxt.pn * tstep : cB;
        for (int t = 0; t < nt; t += 2) {
            const bool last = (t == nt - 2);
            const char* a1 = cA + (size_t)(t + 1) * kstep;
            const char* a2 = last ? nA : cA + (size_t)(t + 2) * kstep; const char* b2 = last ? nB : cB + (size_t)(t + 2) * kstep;
            const char* a3 = a2 + kstep; const char* b3 = b2 + kstep;
            if (last && has_next) S.a_ready(nxt);
            if constexpr (SP2) {
            PG8_LDB(B0, 0, 0); PG8_LDB(B1, 0, 1); PG8_SCHED; PG8_LDA(At, 0, 0); PG8_STAGE(PG8_SA(1, 1), a1 + hstep, voffA);
            PG8_WAIT_V(8); PG8_WAIT_L(0); PG8_BAR; PG8_MMA(0, 0, At, B0); PG8_MMA(0, 1, At, B1); PG8_BAR; PG8_SCHED;
            PG8_LDA(At, 0, 1); PG8_STAGE(PG8_SB(0, 0), b2, voffB); PG8_STAGE(PG8_SB(0, 1), b2 + hstep, voffB); PG8_STAGE(PG8_SA(0, 0), a2, voffA);
            PG8_WAIT_V(8); PG8_WAIT_L(0); PG8_BAR; PG8_MMA(1, 0, At, B0); PG8_MMA(1, 1, At, B1); PG8_BAR; PG8_SCHED;
            PG8_LDB(B0, 1, 0); PG8_LDB(B1, 1, 1); PG8_SCHED; PG8_LDA(At, 1, 0); PG8_STAGE(PG8_SA(0, 1), a2 + hstep, voffA);
            PG8_WAIT_V(8); PG8_WAIT_L(0); PG8_BAR; PG8_MMA(0, 0, At, B0); PG8_MMA(0, 1, At, B1); PG8_BAR; PG8_SCHED;
            PG8_LDA(At, 1, 1); PG8_STAGE(PG8_SB(1, 0), b3, voffB); PG8_STAGE(PG8_SB(1, 1), b3 + hstep, voffB); PG8_STAGE(PG8_SA(1, 0), a3, voffA);
            PG8_WAIT_V(8); PG8_WAIT_L(0); PG8_BAR; PG8_MMA(1, 0, At, B0); PG8_MMA(1, 1, At, B1); PG8_BAR; PG8_SCHED;
            } else {
            PG8_LDB(B0, 0, 0); PG8_SCHED; PG8_LDA(At, 0, 0); PG8_STAGE(PG8_SA(1, 1), a1 + hstep, voffA);
            PG8_WAIT_L(8); PG8_BAR; PG8_WAIT_L(0); PG8_MMA(0, 0, At, B0); PG8_BAR; PG8_SCHED;
            PG8_LDB(B1, 0, 1); PG8_STAGE(PG8_SB(0, 0), b2, voffB);
            PG8_BAR; PG8_WAIT_L(0); PG8_MMA(0, 1, At, B1); PG8_BAR;
            PG8_LDA(At, 0, 1); PG8_STAGE(PG8_SA(0, 0), a2, voffA);
            PG8_BAR; PG8_WAIT_L(0); PG8_MMA(1, 0, At, B0); PG8_BAR; PG8_SCHED;
            PG8_STAGE(PG8_SB(0, 1), b2 + hstep, voffB);
            PG8_WAIT_V(6); PG8_BAR; PG8_MMA(1, 1, At, B1); PG8_BAR;
            PG8_LDB(B0, 1, 0); PG8_SCHED; PG8_LDA(At, 1, 0); PG8_STAGE(PG8_SA(0, 1), a2 + hstep, voffA);
            PG8_WAIT_L(8); PG8_BAR; PG8_WAIT_L(0); PG8_MMA(0, 0, At, B0); PG8_BAR; PG8_SCHED;
            PG8_LDB(B1, 1, 1); PG8_STAGE(PG8_SB(1, 0), b3, voffB);
            PG8_BAR; PG8_WAIT_L(0); PG8_MMA(0, 1, At, B1); PG8_BAR;
            PG8_LDA(At, 1, 1); PG8_STAGE(PG8_SA(1, 0), a3, voffA);
            PG8_BAR; PG8_WAIT_L(0); PG8_MMA(1, 0, At, B0); PG8_BAR; PG8_SCHED;
            PG8_STAGE(PG8_SB(1, 1), b3 + hstep, voffB);
            PG8_WAIT_V(6); PG8_BAR; PG8_MMA(1, 1, At, B1); PG8_BAR;
            }
        }
        if constexpr (ALIGN_EPI) { if (wr == 0) PG8_BAR; }
        if constexpr (!Epi::AFTER_DRAIN) { E(acc, cur, wr, wc, fr, fq); S.done(cur); }
        if (!has_next) break;
#pragma unroll
        for (int a = 0; a < 2; ++a)
#pragma unroll
            for (int b = 0; b < 2; ++b)
#pragma unroll
                for (int m = 0; m < 4; ++m)
#pragma unroll
                    for (int n = 0; n < 2; ++n) acc[a][b][m][n] = (f32x4){0.f, 0.f, 0.f, 0.f};
        cur = nxt; cA = nA; cB = nB; ++ui;
        if constexpr (ALIGN_EPI) { if (wr == 1) PG8_BAR; }
    }
    PG8_WAIT_V(0);
    if constexpr (!ALIGN_EPI) { if (wr == 0) PG8_BAR; }
    PG8_BAR;
    if constexpr (Epi::AFTER_DRAIN) { E.fused(acc, cur, wr, wc, fr, fq, lds, wid, lane); S.done(cur); }
#undef PG8_SA
#undef PG8_SB
#undef PG8_STAGE
#undef PG8_LDA
#undef PG8_LDB
#undef PG8_MMA
#undef PG8_WAIT_V
#undef PG8_WAIT_L
#undef PG8_BAR
#undef PG8_SCHED
}
}
constexpr int NWAVES = 8;
constexpr int BATCH = 8, SEQ = 2048, DM = 1024, M = BATCH * SEQ, FFN = 2816, NMEM = 256, DEPTH = 4;
constexpr int MROWS = BATCH * NMEM;
constexpr int AB_IN = 2240, AB_INP = 2304, C_IN = 1224, C_INP = 1280;
constexpr float EPS = 1e-6f;
constexpr float LOG2E = 1.4426950408889634f;
constexpr int U_CQ = 0, U_CKV = 384, U_KR = 640, U_XM = 704, U_VM = 1216, U_OG = 1728;
constexpr int V_CQ = 0, V_CKV = 384, V_QI = 640, V_KI = 1152, V_WI = 1216;

constexpr size_t MiB = 1u << 20;
constexpr size_t WS_CTL = 0, CTL_BYTES = 1 * MiB;
constexpr size_t WS_WGU = 1 * MiB;
constexpr size_t WS_WDN = WS_WGU + 22 * MiB;
constexpr size_t WS_WXQ = WS_WDN + 11 * MiB;
constexpr size_t WS_WXKV = WS_WXQ + 1 * MiB;
constexpr size_t WS_WXO = WS_WXKV + 2 * MiB;
constexpr size_t WS_WIN = WS_WXO + 1 * MiB;
constexpr size_t WS_WOUT = WS_WIN + 5 * MiB;
constexpr size_t WS_WUQ = WS_WOUT + 2 * MiB;
constexpr size_t WS_WUKV = WS_WUQ + 1 * MiB;
constexpr size_t WS_WQK = WS_WUKV + 1 * MiB;
constexpr size_t WS_WGEFF = WS_WQK + 1 * MiB;
constexpr size_t WS_MEMN = WS_WGEFF + 1 * MiB;
constexpr size_t WS_KVX = WS_MEMN + 4 * MiB;
constexpr size_t WS_ROPE = WS_KVX + 4 * MiB;
constexpr size_t WS_XB = WS_ROPE + 4 * MiB;
constexpr size_t WS_Y = WS_XB + 32 * MiB;
constexpr size_t WS_BIG = WS_Y + 32 * MiB;
constexpr size_t WS_ACT = WS_BIG;
constexpr size_t WS_U = WS_BIG;
constexpr size_t WS_CQN = WS_U + 72 * MiB;
constexpr size_t WS_CKVN = WS_CQN + 12 * MiB;
constexpr size_t WS_KR = WS_CKVN + 8 * MiB;
constexpr size_t WS_XC = WS_KR + 2 * MiB;
constexpr size_t WS_GATE = WS_XC + 16 * MiB;
constexpr size_t WS_FG = WS_GATE + 1 * MiB;
constexpr size_t WS_QA = WS_FG + 1 * MiB;
constexpr size_t WS_KVA = WS_QA + 32 * MiB;
constexpr size_t WS_QKM = WS_KVA + 64 * MiB;
constexpr size_t WS_HM = WS_QKM + 32 * MiB;
constexpr size_t WS_MIX = WS_HM + 16 * MiB;
constexpr size_t WS_BM = WS_MIX + 32 * MiB;
constexpr size_t WS_QX = WS_U;
constexpr size_t WS_OX = WS_U + 16 * MiB;
constexpr size_t WS_END = WS_BM + 4 * MiB;
static_assert(WS_ACT + (size_t)M * FFN * 2 <= WS_END, "ACT fits the big region");
static_assert(WS_END <= 440 * MiB, "d_ws budget");
constexpr int CW_BAR = 4096;

constexpr int RING_BYTES = 131072;
constexpr int LDSCTL_OFF = 147456 - 1024, MISC_OFF = LDSCTL_OFF + 320;
constexpr int LDS_BYTES = 147456;

#define GAS __attribute__((address_space(1)))
#define LAS __attribute__((address_space(3)))
typedef unsigned short bf16;
typedef unsigned v4u __attribute__((ext_vector_type(4)));
typedef unsigned v2u __attribute__((ext_vector_type(2)));
typedef float f32x4 __attribute__((ext_vector_type(4)));
#define LDS_WAIT() asm volatile("s_waitcnt lgkmcnt(0)" ::: "memory")
#define VM_WAIT() asm volatile("s_waitcnt vmcnt(0)" ::: "memory")
__device__ __forceinline__ unsigned f2bf(float f) { unsigned u = __builtin_bit_cast(unsigned, f); return (u + 0x7fffu + ((u >> 16) & 1u)) >> 16; }
__device__ __forceinline__ unsigned pk2(float lo, float hi) { return f2bf(lo) | (f2bf(hi) << 16); }
__device__ __forceinline__ float bflo(unsigned w) { return __uint_as_float(w << 16); }
__device__ __forceinline__ float bfhi(unsigned w) { return __uint_as_float(w & 0xffff0000u); }
__device__ __forceinline__ float bf2f(bf16 b) { return __uint_as_float((unsigned)b << 16); }
__device__ __forceinline__ void unpack8(const v4u w, float (&f)[8]) { f[0] = bflo(w.x); f[1] = bfhi(w.x); f[2] = bflo(w.y); f[3] = bfhi(w.y); f[4] = bflo(w.z); f[5] = bfhi(w.z); f[6] = bflo(w.w); f[7] = bfhi(w.w); }
__device__ __forceinline__ v4u pack8(const float (&f)[8]) { v4u w; w.x = pk2(f[0], f[1]); w.y = pk2(f[2], f[3]); w.z = pk2(f[4], f[5]); w.w = pk2(f[6], f[7]); return w; }
#define SWZ_XOR(v, x) __uint_as_float((unsigned)__builtin_amdgcn_ds_swizzle((int)__float_as_uint(v), 0x1f | ((x) << 10)))
__device__ __forceinline__ float wave_sum(float v) {
    v += SWZ_XOR(v, 1); v += SWZ_XOR(v, 2); v += SWZ_XOR(v, 4); v += SWZ_XOR(v, 8); v += SWZ_XOR(v, 16);
    const auto rr = __builtin_amdgcn_permlane32_swap(__float_as_uint(v), __float_as_uint(v), false, false);
    return __uint_as_float(rr[0]) + __uint_as_float(rr[1]);
}
__device__ __forceinline__ float wave_max(float v) {
    v = fmaxf(v, SWZ_XOR(v, 1)); v = fmaxf(v, SWZ_XOR(v, 2)); v = fmaxf(v, SWZ_XOR(v, 4)); v = fmaxf(v, SWZ_XOR(v, 8)); v = fmaxf(v, SWZ_XOR(v, 16));
    const auto rr = __builtin_amdgcn_permlane32_swap(__float_as_uint(v), __float_as_uint(v), false, false);
    return fmaxf(__uint_as_float(rr[0]), __uint_as_float(rr[1]));
}
__device__ __forceinline__ float rdlane(float v, int l) { return __uint_as_float((unsigned)__builtin_amdgcn_readlane((int)__float_as_uint(v), l)); }
#define XB_TMO      128
#define XB_XCNT(j)  (256  + 64 * (j))
#define XB_XSUB(j)  (1280 + 64 * (j))
#define XB_XGEN(j)  (2304 + 64 * (j))
#define XB_TOP      3328
#define XB_TOPGEN   3392
#define XCD_BAR_WORDS 3456
#define XB_SPIN_CAP (1u << 18)

__device__ __forceinline__ unsigned xb_ld(unsigned* p)              { return __hip_atomic_load(p, __ATOMIC_RELAXED, __HIP_MEMORY_SCOPE_AGENT); }
__device__ __forceinline__ unsigned xb_add(unsigned* p, unsigned v) { return __hip_atomic_fetch_add(p, v, __ATOMIC_RELAXED, __HIP_MEMORY_SCOPE_AGENT); }
__device__ __forceinline__ unsigned xb_xcc_id() { return (unsigned)__builtin_amdgcn_s_getreg((3 << 11) | 20) & 0xFu; }
#define XB_SPIN(cond, bar) do { unsigned _sp = 0; while (cond) { __builtin_amdgcn_s_sleep(1); \
    if ((++_sp & 255u) == 0u) { if (xb_ld(&(bar)[XB_TMO])) break; if (_sp > XB_SPIN_CAP) { atomicAdd(&(bar)[XB_TMO], 1u); break; } } } } while (0)

struct XcdBarrier {
    unsigned* bar; unsigned x;
    volatile LAS unsigned* st;
};

__device__ __forceinline__ XcdBarrier xcd_barrier_post(unsigned* bar, volatile LAS unsigned* st) {
    XcdBarrier b; b.bar = bar; b.x = xb_xcc_id(); b.st = st;
    if (threadIdx.x == 0) (void)xb_add(&bar[XB_XCNT(b.x)], 1u);
    return b;
}
__device__ __forceinline__ void xcd_barrier_complete(unsigned* bar, unsigned x, unsigned& nloc, unsigned& nx) {
    const unsigned G = gridDim.x * gridDim.y * gridDim.z;
    unsigned sum, cnt, mine, sp = 0u;
    for (;;) {
        sum = 0u; cnt = 0u; mine = 0u;
#pragma unroll
        for (unsigned j = 0; j < 16; ++j) { const unsigned c = xb_ld(&bar[XB_XCNT(j)]); sum += c; cnt += (c > 0u) ? 1u : 0u; mine = (j == x) ? c : mine; }
        if (sum == G) break;
        __builtin_amdgcn_s_sleep(1);
        if ((++sp & 255u) == 0u) { if (xb_ld(&bar[XB_TMO])) break; if (sp > XB_SPIN_CAP) { atomicAdd(&bar[XB_TMO], 1u); break; } }
    }
    nloc = mine > 0u ? mine : 1u; nx = cnt > 0u ? cnt : 1u;
}

__device__ __forceinline__ void xcd_barrier(const XcdBarrier& b) {
    asm volatile("s_waitcnt vmcnt(0)" ::: "memory");
    __syncthreads();
    if (threadIdx.x == 0) {
        unsigned* bar = b.bar; asm volatile("" : "+s"(bar));
        __builtin_amdgcn_s_waitcnt(0);
        unsigned nloc = b.st[0], nx = b.st[1];
        if (nloc == 0u) { xcd_barrier_complete(bar, b.x, nloc, nx); b.st[0] = nloc; b.st[1] = nx; }
        const unsigned old = xb_add(&bar[XB_XSUB(b.x)], 1u);
        const unsigned gen = old / nloc;
        if (old + 1u == (gen + 1u) * nloc) {
            __builtin_amdgcn_fence(__ATOMIC_RELEASE, "agent");
            asm volatile("s_waitcnt vmcnt(0)" ::: "memory");
            const unsigned og = xb_add(&bar[XB_TOP], 1u);
            const unsigned tg = og / nx;
            if (og + 1u == (tg + 1u) * nx) xb_add(&bar[XB_TOPGEN], 1u);
            else XB_SPIN(xb_ld(&bar[XB_TOPGEN]) == tg, bar);
            __builtin_amdgcn_fence(__ATOMIC_ACQUIRE, "agent");
            xb_add(&bar[XB_XGEN(b.x)], 1u);
            asm volatile("s_waitcnt vmcnt(0)" ::: "memory");
        } else {
            XB_SPIN(xb_ld(&bar[XB_XGEN(b.x)]) == gen, bar);
            __builtin_amdgcn_fence(__ATOMIC_ACQUIRE, "agent");
            asm volatile("s_waitcnt vmcnt(0)" ::: "memory");
        }
    }
    __syncthreads();
}
struct Params { const float* in[33]; float* out; unsigned char* ws; int st_lo, st_hi; };
struct Frame { LAS unsigned char* lds; int tid, lane, wave, G, gw, NGW; };
enum { I_X = 0, I_MEM, I_POS, I_NORMG, I_MEMG, I_WG, I_WU, I_WD, I_XQ, I_XK, I_XV, I_XO, I_ABIN, I_ABOUT, I_ACQG, I_ACKVG, I_AUQ, I_AUKV, I_CONVW, I_CONVB, I_MLWQ, I_MLWK,
       I_WGATES, I_BGATES, I_GNG, I_SKIP, I_CIN, I_COUT, I_CCQG, I_CCKVG, I_CUQ, I_CUK, I_CUV };

struct MapId { int off; __device__ __forceinline__ int operator()(int n) const { return off + n; } };
struct MapGU { int off; __device__ __forceinline__ int operator()(int n) const { return ((n >> 7) << 8) + (n & 127) + off; } };
struct MapRopeQ { __device__ __forceinline__ int operator()(int n) const { const int h = n / 192, w = n % 192; return w < 128 ? n : h * 192 + 128 + 2 * ((w - 128) & 31) + ((w - 128) >> 5); } };
template <class Map>
__device__ __forceinline__ void tr_item(const float* __restrict__ W, int ldw, int Nvalid, int k0, int n0, bf16* WT, int ldt, int dcol0, float scale, const Map& map, LAS float* scr, int lane) {
    const int nn = lane & 31; const bool ok = (n0 + nn) < Nvalid;
#pragma unroll 8
    for (int i = 0; i < 32; ++i) { const int kk = 2 * i + (lane >> 5); scr[kk * 33 + nn] = ok ? W[(size_t)(k0 + kk) * ldw + n0 + nn] * scale : 0.f; }
    LDS_WAIT(); asm volatile("" ::: "memory");
    const int c = lane & 7;
#pragma unroll
    for (int j = 0; j < 4; ++j) { const int n = (lane >> 3) + 8 * j; const LAS float* s = scr + (8 * c) * 33 + n;
        v4u o; o.x = pk2(s[0 * 33], s[1 * 33]); o.y = pk2(s[2 * 33], s[3 * 33]); o.z = pk2(s[4 * 33], s[5 * 33]); o.w = pk2(s[6 * 33], s[7 * 33]);
        *(v4u*)(WT + (size_t)map(n0 + n) * ldt + dcol0 + k0 + 8 * c) = o; }
    LDS_WAIT(); asm volatile("" ::: "memory");
}
template <class Map>
__device__ __forceinline__ void conv_mat(const Frame& F, int& cur, const float* W, int K, int N, int ldw, bf16* WT, int ldt, int dcol0, float scale, const Map& map) {
    LAS float* scr = (LAS float*)(F.lds + F.wave * 16384);
    const int nblk = (N + 31) / 32, nitems = (K / 64) * nblk;
    int first = F.gw - cur; if (first < 0) first += F.NGW;
    for (int it = first; it < nitems; it += F.NGW) { const int kb = it / nblk, nb = it % nblk; tr_item(W, ldw, N, 64 * kb, 32 * nb, WT, ldt, dcol0, scale, map, scr, F.lane); }
    cur = (cur + nitems) % F.NGW;
}
__device__ __forceinline__ void zero_bytes(const Frame& F, void* p, size_t nbytes) {
    const size_t n16 = nbytes / 16; unsigned zz = 0u; asm volatile("" : "+v"(zz)); const v4u z = {zz, zz, zz, zz};
    for (size_t i = (size_t)blockIdx.x * 512 + F.tid; i < n16; i += (size_t)F.G * 512) ((v4u*)p)[i] = z;
}

__device__ __forceinline__ void ld_row_f32(const float* p, int lane, float (&v)[16]) {
#pragma unroll
    for (int j = 0; j < 2; ++j) { const f32x4 a = *(const f32x4*)(p + 512 * j + 8 * lane), b = *(const f32x4*)(p + 512 * j + 8 * lane + 4);
        v[8 * j + 0] = a[0]; v[8 * j + 1] = a[1]; v[8 * j + 2] = a[2]; v[8 * j + 3] = a[3]; v[8 * j + 4] = b[0]; v[8 * j + 5] = b[1]; v[8 * j + 6] = b[2]; v[8 * j + 7] = b[3]; }
}
__device__ __forceinline__ void st_row_f32(float* p, int lane, const float (&v)[16]) {
#pragma unroll
    for (int j = 0; j < 2; ++j) { *(f32x4*)(p + 512 * j + 8 * lane) = (f32x4){v[8 * j + 0], v[8 * j + 1], v[8 * j + 2], v[8 * j + 3]}; *(f32x4*)(p + 512 * j + 8 * lane + 4) = (f32x4){v[8 * j + 4], v[8 * j + 5], v[8 * j + 6], v[8 * j + 7]}; }
}
__device__ __forceinline__ void ld_row_bf16(const bf16* p, int lane, float (&v)[16]) {
#pragma unroll
    for (int j = 0; j < 2; ++j) { const v4u w = *(const v4u*)(p + 512 * j + 8 * lane); float f[8]; unpack8(w, f);
#pragma unroll
        for (int e = 0; e < 8; ++e) v[8 * j + e] = f[e]; }
}
__device__ __forceinline__ void st_row_bf16(bf16* p, int lane, const float (&v)[16]) {
#pragma unroll
    for (int j = 0; j < 2; ++j) { v4u w; w.x = pk2(v[8 * j + 0], v[8 * j + 1]); w.y = pk2(v[8 * j + 2], v[8 * j + 3]); w.z = pk2(v[8 * j + 4], v[8 * j + 5]); w.w = pk2(v[8 * j + 6], v[8 * j + 7]); *(v4u*)(p + 512 * j + 8 * lane) = w; }
}
__device__ __forceinline__ float ssq16(const float (&v)[16]) { float s = 0.f;
#pragma unroll
    for (int e = 0; e < 16; ++e) s += v[e] * v[e];
    return wave_sum(s); }
__device__ __forceinline__ void t_norm(const Frame& F, const float* xin, float* xout, const bf16* Y, float cmul, const float* gpost, const float* gpre, bf16* XB) {
    for (int m = F.gw; m < M; m += F.NGW) {
        float x[16]; ld_row_f32(xin + (size_t)m * DM, F.lane, x);
        if (Y) { float y[16], g[16]; ld_row_bf16(Y + (size_t)m * DM, F.lane, y); ld_row_f32(gpost, F.lane, g);
            const float rs = cmul * __builtin_amdgcn_rsqf(ssq16(y) * (1.0f / DM) + EPS);
#pragma unroll
            for (int e = 0; e < 16; ++e) x[e] += y[e] * rs * g[e]; }
        st_row_f32(xout + (size_t)m * DM, F.lane, x);
        if (gpre) { float g[16]; ld_row_f32(gpre, F.lane, g); const float rs = __builtin_amdgcn_rsqf(ssq16(x) * (1.0f / DM) + EPS);
#pragma unroll
            for (int e = 0; e < 16; ++e) x[e] = x[e] * rs * g[e];
            st_row_bf16(XB + (size_t)m * DM, F.lane, x); }
    }
}
__device__ __forceinline__ void t_memn(const Frame& F, const float* mem, const float* g, bf16* MEMN) {
    for (int m = F.gw; m < MROWS; m += F.NGW) { float x[16], gg[16]; ld_row_f32(mem + (size_t)m * DM, F.lane, x); ld_row_f32(g, F.lane, gg);
        const float rs = __builtin_amdgcn_rsqf(ssq16(x) * (1.0f / DM) + EPS);
#pragma unroll
        for (int e = 0; e < 16; ++e) x[e] = x[e] * rs * gg[e];
        st_row_bf16(MEMN + (size_t)m * DM, F.lane, x); }
}
__device__ __forceinline__ void t_rope_table(const Frame& F, const int* pos, float* ROPE) {
    for (int idx = blockIdx.x * 512 + F.tid; idx < M * 32; idx += F.G * 512) { const int m = idx >> 5, i = idx & 31;
        const float inv = __builtin_amdgcn_exp2f(-(float)i * (13.287712379549449f / 32.0f));
        const double rev = (double)pos[m] * (double)inv * 0.15915494309189535;
        const float fr = (float)(rev - __builtin_floor(rev));
        ROPE[2 * idx] = __builtin_amdgcn_cosf(fr); ROPE[2 * idx + 1] = __builtin_amdgcn_sinf(fr); }
}
__device__ __forceinline__ void t_weff(const Frame& F, const float* wq, const float* wk, const float* wg, float* WGEFF) {
    for (int idx = blockIdx.x * 512 + F.tid; idx < 1024 * 8; idx += F.G * 512) { const int k = idx >> 3, g = idx & 7; float s;
        if (k < 512) { const int h = k >> 7, d = k & 127; const float* q = wq + ((size_t)h * 128 + d) * 128; const float* kk = wk + ((size_t)h * 128 + d) * 128; s = 0.f;
            for (int e = 0; e < 128; ++e) s += q[e] * wg[(size_t)(h * 128 + e) * 8 + g] + kk[e] * wg[(size_t)(512 + h * 128 + e) * 8 + g]; }
        else s = wg[(size_t)(1024 + (k - 512)) * 8 + g];
        WGEFF[idx] = s; }
}
__device__ __forceinline__ float log_sigmoid(float x) {
    const float y = __expf(-fabsf(x));
    const float l1p = (y < 0.02f) ? y * (1.0f - y * (0.5f - y * (0.33333333f - 0.25f * y))) : __logf(1.0f + y);
    return fminf(x, 0.f) - l1p;
}
__device__ __forceinline__ void t_prep_even(const Frame& F, const bf16* U, const float* cqg, const float* ckvg, const float* ROPE, const float* convw, const float* convb,
                                            const float* WGEFF, const float* bgates, bf16* CQN, bf16* CKVN, bf16* KR, bf16* XC, float* GATE) {
    const int lane = F.lane;
    for (int m = F.gw; m < M; m += F.NGW) { const bf16* u = U + (size_t)m * AB_INP; const int t = m & (SEQ - 1);
        { float v[8]; float s = 0.f; if (lane < 48) { unpack8(*(const v4u*)(u + U_CQ + 8 * lane), v);
#pragma unroll
                for (int e = 0; e < 8; ++e) s += v[e] * v[e]; }
          const float rs = __builtin_amdgcn_rsqf(wave_sum(s) * (1.0f / 384.0f) + EPS);
          if (lane < 48) { const f32x4 g0 = *(const f32x4*)(cqg + 8 * lane), g1 = *(const f32x4*)(cqg + 8 * lane + 4);
              float o[8] = {v[0] * rs * g0[0], v[1] * rs * g0[1], v[2] * rs * g0[2], v[3] * rs * g0[3], v[4] * rs * g1[0], v[5] * rs * g1[1], v[6] * rs * g1[2], v[7] * rs * g1[3]};
              *(v4u*)(CQN + (size_t)m * 384 + 8 * lane) = pack8(o); } }
        { float v[8]; float s = 0.f; if (lane < 32) { unpack8(*(const v4u*)(u + U_CKV + 8 * lane), v);
#pragma unroll
                for (int e = 0; e < 8; ++e) s += v[e] * v[e]; }
          const float rs = __builtin_amdgcn_rsqf(wave_sum(s) * (1.0f / 256.0f) + EPS);
          if (lane < 32) { const f32x4 g0 = *(const f32x4*)(ckvg + 8 * lane), g1 = *(const f32x4*)(ckvg + 8 * lane + 4);
              float o[8] = {v[0] * rs * g0[0], v[1] * rs * g0[1], v[2] * rs * g0[2], v[3] * rs * g0[3], v[4] * rs * g1[0], v[5] * rs * g1[1], v[6] * rs * g1[2], v[7] * rs * g1[3]};
              *(v4u*)(CKVN + (size_t)m * 256 + 8 * lane) = pack8(o); } }
        if (lane < 32) { const float x1 = bf2f(u[U_KR + lane]), x2 = bf2f(u[U_KR + 32 + lane]); const float c = ROPE[((size_t)m * 32 + lane) * 2], sn = ROPE[((size_t)m * 32 + lane) * 2 + 1];
            *(unsigned*)(KR + (size_t)m * 64 + 2 * lane) = pk2(x1 * c - x2 * sn, x1 * sn + x2 * c); }
        float xc[8];
        { const f32x4 b0 = *(const f32x4*)(convb + 8 * lane), b1 = *(const f32x4*)(convb + 8 * lane + 4);
          float a[8] = {b0[0], b0[1], b0[2], b0[3], b1[0], b1[1], b1[2], b1[3]};
#pragma unroll
          for (int j = 0; j < 4; ++j) { if (t - 3 + j >= 0) { float v[8]; unpack8(*(const v4u*)(u + (ptrdiff_t)(j - 3) * AB_INP + U_XM + 8 * lane), v);
                  const f32x4 w0 = *(const f32x4*)(convw + j * 512 + 8 * lane), w1 = *(const f32x4*)(convw + j * 512 + 8 * lane + 4);
                  a[0] += v[0] * w0[0]; a[1] += v[1] * w0[1]; a[2] += v[2] * w0[2]; a[3] += v[3] * w0[3]; a[4] += v[4] * w1[0]; a[5] += v[5] * w1[1]; a[6] += v[6] * w1[2]; a[7] += v[7] * w1[3]; } }
#pragma unroll
          for (int e = 0; e < 8; ++e) xc[e] = a[e] * __builtin_amdgcn_rcpf(1.0f + __expf(-a[e]));
          *(v4u*)(XC + (size_t)m * 512 + 8 * lane) = pack8(xc); }
        { float vm[8]; unpack8(*(const v4u*)(u + U_VM + 8 * lane), vm); float gs[8];
#pragma unroll
          for (int g = 0; g < 8; ++g) gs[g] = 0.f;
#pragma unroll
          for (int e = 0; e < 8; ++e) { const f32x4 a0 = *(const f32x4*)(WGEFF + (size_t)(8 * lane + e) * 8), a1 = *(const f32x4*)(WGEFF + (size_t)(8 * lane + e) * 8 + 4);
              const f32x4 c0 = *(const f32x4*)(WGEFF + (size_t)(512 + 8 * lane + e) * 8), c1 = *(const f32x4*)(WGEFF + (size_t)(512 + 8 * lane + e) * 8 + 4);
              gs[0] += xc[e] * a0[0] + vm[e] * c0[0]; gs[1] += xc[e] * a0[1] + vm[e] * c0[1]; gs[2] += xc[e] * a0[2] + vm[e] * c0[2]; gs[3] += xc[e] * a0[3] + vm[e] * c0[3];
              gs[4] += xc[e] * a1[0] + vm[e] * c1[0]; gs[5] += xc[e] * a1[1] + vm[e] * c1[1]; gs[6] += xc[e] * a1[2] + vm[e] * c1[2]; gs[7] += xc[e] * a1[3] + vm[e] * c1[3]; }
#pragma unroll
          for (int g = 0; g < 8; ++g) gs[g] = wave_sum(gs[g]) + bgates[g];
          if (lane == 0) { *(f32x4*)(GATE + (size_t)m * 8) = (f32x4){gs[0], gs[1], gs[2], gs[3]};
              *(f32x4*)(GATE + (size_t)m * 8 + 4) = (f32x4){log_sigmoid(gs[4]), log_sigmoid(gs[5]), log_sigmoid(gs[6]), log_sigmoid(gs[7])}; } }
    }
}
__device__ __forceinline__ void t_scan(const Frame& F, const float* GATE, float* FG, int seq) {
    const int b = seq >> 2, h = seq & 3, lane = F.lane; const size_t m0 = (size_t)b * SEQ + 32 * lane;
    float lf[32]; float run = 0.f;
#pragma unroll
    for (int i = 0; i < 32; ++i) { run += GATE[(m0 + i) * 8 + 4 + h]; lf[i] = run; }
    float pre = run;
#pragma unroll
    for (int o = 1; o < 64; o <<= 1) { const float t = __uint_as_float((unsigned)__builtin_amdgcn_ds_bpermute((lane - o) * 4, (int)__float_as_uint(pre))); if (lane >= o) pre += t; }
    const float base = pre - run;
#pragma unroll
    for (int i = 0; i < 32; ++i) { const float Fv = base + lf[i]; const float li = GATE[(m0 + i) * 8 + h];
        FG[((m0 + i) * 4 + h) * 2] = Fv * LOG2E; FG[((m0 + i) * 4 + h) * 2 + 1] = (li - Fv) * LOG2E; }
}
__device__ __forceinline__ void t_mix(const Frame& F, const bf16* HM, const bf16* XC, const bf16* U, const float* gng, const float* skip, bf16* MIX) {
    const int lane = F.lane;
    for (int m = F.gw; m < M; m += F.NGW) { float h[8], xc[8], og[8];
        unpack8(*(const v4u*)(HM + (size_t)m * 512 + 8 * lane), h); unpack8(*(const v4u*)(XC + (size_t)m * 512 + 8 * lane), xc); unpack8(*(const v4u*)(U + (size_t)m * AB_INP + U_OG + 8 * lane), og);
        float s = 0.f;
#pragma unroll
        for (int e = 0; e < 8; ++e) s += h[e];
        s += SWZ_XOR(s, 1); s += SWZ_XOR(s, 2); s += SWZ_XOR(s, 4); s += SWZ_XOR(s, 8);
        const float mu = s * (1.0f / 128.0f); float q = 0.f;
#pragma unroll
        for (int e = 0; e < 8; ++e) { h[e] -= mu; q += h[e] * h[e]; }
        q += SWZ_XOR(q, 1); q += SWZ_XOR(q, 2); q += SWZ_XOR(q, 4); q += SWZ_XOR(q, 8);
        const float rs = __builtin_amdgcn_rsqf(q * (1.0f / 128.0f) + EPS);
        const f32x4 g0 = *(const f32x4*)(gng + 8 * lane), g1 = *(const f32x4*)(gng + 8 * lane + 4), k0 = *(const f32x4*)(skip + 8 * lane), k1 = *(const f32x4*)(skip + 8 * lane + 4);
        const float gg[8] = {g0[0], g0[1], g0[2], g0[3], g1[0], g1[1], g1[2], g1[3]}, kk[8] = {k0[0], k0[1], k0[2], k0[3], k1[0], k1[1], k1[2], k1[3]}; float o[8];
#pragma unroll
        for (int e = 0; e < 8; ++e) o[e] = (h[e] * rs * gg[e] + kk[e] * xc[e]) * __builtin_amdgcn_rcpf(1.0f + __expf(-og[e]));
        *(v4u*)(MIX + (size_t)m * DM + 512 + 8 * lane) = pack8(o); }
}
__device__ __forceinline__ void t_prep_odd(const Frame& F, const bf16* U, const float* cqg, const float* ckvg, bf16* CQN, bf16* CKVN) {
    const int lane = F.lane;
    for (int m = F.gw; m < M; m += F.NGW) { const bf16* u = U + (size_t)m * C_INP;
        { float v[8]; float s = 0.f; if (lane < 48) { unpack8(*(const v4u*)(u + V_CQ + 8 * lane), v);
#pragma unroll
                for (int e = 0; e < 8; ++e) s += v[e] * v[e]; }
          const float rs = __builtin_amdgcn_rsqf(wave_sum(s) * (1.0f / 384.0f) + EPS);
          if (lane < 48) { const f32x4 g0 = *(const f32x4*)(cqg + 8 * lane), g1 = *(const f32x4*)(cqg + 8 * lane + 4);
              float o[8] = {v[0] * rs * g0[0], v[1] * rs * g0[1], v[2] * rs * g0[2], v[3] * rs * g0[3], v[4] * rs * g1[0], v[5] * rs * g1[1], v[6] * rs * g1[2], v[7] * rs * g1[3]};
              *(v4u*)(CQN + (size_t)m * 384 + 8 * lane) = pack8(o); } }
        { float v[8]; float s = 0.f; if (lane < 32) { unpack8(*(const v4u*)(u + V_CKV + 8 * lane), v);
#pragma unroll
                for (int e = 0; e < 8; ++e) s += v[e] * v[e]; }
          const float rs = __builtin_amdgcn_rsqf(wave_sum(s) * (1.0f / 256.0f) + EPS);
          if (lane < 32) { const f32x4 g0 = *(const f32x4*)(ckvg + 8 * lane), g1 = *(const f32x4*)(ckvg + 8 * lane + 4);
              float o[8] = {v[0] * rs * g0[0], v[1] * rs * g0[1], v[2] * rs * g0[2], v[3] * rs * g0[3], v[4] * rs * g1[0], v[5] * rs * g1[1], v[6] * rs * g1[2], v[7] * rs * g1[3]};
              *(v4u*)(CKVN + (size_t)m * 256 + 8 * lane) = pack8(o); } }
    }
}
__device__ __forceinline__ unsigned fkey(float f) { const unsigned u = __float_as_uint(f); return (u & 0x80000000u) ? ~u : (u | 0x80000000u); }
__device__ __forceinline__ void topk_bitmap(const LAS float* row, int t, unsigned* bmrow, int lane) {
    unsigned u[32];
#pragma unroll
    for (int i = 0; i < 32; ++i) u[i] = (lane <= t - 64 * i) ? fkey(row[lane + 64 * i]) : 0u;
    unsigned tau = 0u;
#pragma unroll 1
    for (int bit = 31; bit >= 0; --bit) { const unsigned cand = tau | (1u << bit); int cnt = 0;
#pragma unroll
        for (int i = 0; i < 32; ++i) cnt += __popcll(__ballot(u[i] >= cand));
        if (cnt >= 256) tau = cand; }
    int cgt = 0;
#pragma unroll
    for (int i = 0; i < 32; ++i) cgt += __popcll(__ballot(u[i] > tau));
    int rem = 256 - cgt; unsigned myword = 0u;
#pragma unroll
    for (int i = 0; i < 32; ++i) { const unsigned long long gt = __ballot(u[i] > tau), eq = __ballot(u[i] == tau); const int pc = __popcll(eq); unsigned long long sel;
        if (pc <= rem) { sel = eq; rem -= pc; }
        else { const int rank = __popcll(eq & ((1ull << lane) - 1ull)); sel = __ballot(u[i] == tau && rank < rem); rem = 0; }
        const unsigned long long w = gt | sel;
        { const unsigned wlo = (unsigned)__builtin_amdgcn_readfirstlane((int)(unsigned)w), whi = (unsigned)__builtin_amdgcn_readfirstlane((int)(unsigned)(w >> 32));
          asm volatile("v_writelane_b32 %0, %1, %2" : "+v"(myword) : "s"(wlo), "i"(2 * i));
          asm volatile("v_writelane_b32 %0, %1, %2" : "+v"(myword) : "s"(whi), "i"(2 * i + 1)); } }
    bmrow[lane] = myword;
}
__device__ __forceinline__ void ph_indexer_simple(const Frame& F, const bf16* U, unsigned* BM) {
    const int lane = F.lane; LAS float* qs = (LAS float*)(F.lds + F.wave * 12288); LAS float* sc = qs + 512;
    for (int m = F.gw; m < M; m += F.NGW) { const int t = m & (SEQ - 1), kb = m - t; unsigned* bmrow = BM + (size_t)m * 64;
        if (t < 256) { const int n = t + 1 - 32 * lane; bmrow[lane] = n >= 32 ? 0xffffffffu : (n > 0 ? ((1u << n) - 1u) : 0u); continue; }
        const bf16* u = U + (size_t)m * C_INP;
        { float v[8]; unpack8(*(const v4u*)(u + V_QI + 8 * lane), v);
#pragma unroll
          for (int e = 0; e < 8; ++e) qs[8 * lane + e] = v[e]; }
        float wi[8]; { float v[8]; unpack8(*(const v4u*)(u + V_WI), v);
#pragma unroll
          for (int e = 0; e < 8; ++e) wi[e] = v[e]; }
        LDS_WAIT(); asm volatile("" ::: "memory");
        for (int j0 = 0; j0 <= t; j0 += 64) { const int j = j0 + lane; const bool valid = j <= t;
            const bf16* kr = U + (size_t)(kb + (valid ? j : t)) * C_INP + V_KI;
            float d[8];
#pragma unroll
            for (int h = 0; h < 8; ++h) d[h] = 0.f;
#pragma unroll 1
            for (int c = 0; c < 8; ++c) { asm volatile("" ::: "memory"); float v[8]; unpack8(*(const v4u*)(kr + 8 * c), v);
#pragma unroll
                for (int h = 0; h < 8; ++h) { const f32x4 q0 = *(const LAS f32x4*)(qs + h * 64 + 8 * c), q1 = *(const LAS f32x4*)(qs + h * 64 + 8 * c + 4);
                    d[h] += q0[0] * v[0] + q0[1] * v[1] + q0[2] * v[2] + q0[3] * v[3] + q1[0] * v[4] + q1[1] * v[5] + q1[2] * v[6] + q1[3] * v[7]; } }
            float acc = 0.f;
#pragma unroll
            for (int h = 0; h < 8; ++h) acc += fmaxf(d[h], 0.f) * wi[h];
            sc[j] = valid ? acc : -__builtin_inff(); }
        LDS_WAIT(); asm volatile("" ::: "memory");
        topk_bitmap(sc, t, bmrow, lane);
        LDS_WAIT(); asm volatile("" ::: "memory");
    }
}

struct AttnBufs { const bf16 *qa_, *kva_, *kr_, *qkm_, *u_, *qd_, *kvd_, *qx_, *kvx_; const float* fg_; const unsigned* bm_; bf16 *mix_, *hm_, *ox_; };
template <int MODE>
__device__ __forceinline__ void attn_task(const AttnBufs& A, int m, int h, LAS float* qs, int lane) {
    constexpr int DK = (MODE == 0) ? 192 : 128;
    const int b = m >> 11, t = m & (SEQ - 1), kb = m - t;
    const bf16* qrow = MODE == 0 ? A.qa_ + (size_t)m * 768 + h * 192 : MODE == 1 ? A.qkm_ + (size_t)m * 1024 + h * 128 : MODE == 2 ? A.qd_ + (size_t)m * 1024 + h * 128 : A.qx_ + (size_t)m * 512 + h * 128;
    for (int d = lane; d < DK; d += 64) qs[d] = bf2f(qrow[d]);
    LDS_WAIT(); asm volatile("" ::: "memory");
    const int nkeys = MODE == 3 ? NMEM : t + 1;
    float mrun = -1e30f, l = 0.f, a0 = 0.f, a1 = 0.f;
    for (int j0 = 0; j0 < nkeys; j0 += 64) { asm volatile("" ::: "memory"); const int j = j0 + lane; bool valid = j < nkeys;
        if (MODE == 2) { const unsigned w = A.bm_[(size_t)m * 64 + (j0 >> 5) + (lane >> 5)]; valid = valid && ((w >> (lane & 31)) & 1u); }
        if (!__any(valid)) continue;
        float dot = 0.f, bias = 0.f;
        if (valid) {
            const size_t kr = MODE == 3 ? (size_t)(b * NMEM + j) : (size_t)(kb + j);
            const bf16* kp = MODE == 0 ? A.kva_ + kr * 1024 + h * 256 : MODE == 1 ? A.qkm_ + kr * 1024 + 512 + h * 128 : MODE == 2 ? A.kvd_ + kr * 2048 + h * 128 : A.kvx_ + kr * 1024 + h * 128;
#pragma unroll
            for (int c = 0; c < 16; ++c) { float v[8]; unpack8(*(const v4u*)(kp + 8 * c), v); const f32x4 q0 = *(const LAS f32x4*)(qs + 8 * c), q1 = *(const LAS f32x4*)(qs + 8 * c + 4);
                dot += q0[0] * v[0] + q0[1] * v[1] + q0[2] * v[2] + q0[3] * v[3] + q1[0] * v[4] + q1[1] * v[5] + q1[2] * v[6] + q1[3] * v[7]; }
            if (MODE == 0) { const bf16* kp2 = A.kr_ + kr * 64;
#pragma unroll
                for (int c = 0; c < 8; ++c) { float v[8]; unpack8(*(const v4u*)(kp2 + 8 * c), v); const f32x4 q0 = *(const LAS f32x4*)(qs + 128 + 8 * c), q1 = *(const LAS f32x4*)(qs + 128 + 8 * c + 4);
                    dot += q0[0] * v[0] + q0[1] * v[1] + q0[2] * v[2] + q0[3] * v[3] + q1[0] * v[4] + q1[1] * v[5] + q1[2] * v[6] + q1[3] * v[7]; } }
            if (MODE == 1) bias = A.fg_[(kr * 4 + h) * 2 + 1];
        }
        const float x = MODE == 1 ? bias : dot;
        const float cm = wave_max(valid ? x : -__builtin_inff());
        const float mn = fmaxf(mrun, cm), alpha = __builtin_amdgcn_exp2f(mrun - mn); mrun = mn;
        float p = valid ? __builtin_amdgcn_exp2f(x - mn) : 0.f; if (MODE == 1) p *= dot;
        l = l * alpha + wave_sum(p); a0 *= alpha; a1 *= alpha;
        const int cnt = (nkeys - j0) < 64 ? (nkeys - j0) : 64;
        const size_t vr0 = MODE == 3 ? (size_t)(b * NMEM + j0) : (size_t)(kb + j0);
        const bf16* vbase = MODE == 0 ? A.kva_ + vr0 * 1024 + h * 256 + 128 : MODE == 1 ? A.u_ + vr0 * AB_INP + U_VM + h * 128 : MODE == 2 ? A.kvd_ + vr0 * 2048 + 1024 + h * 128 : A.kvx_ + vr0 * 1024 + 512 + h * 128;
        constexpr int VLD = MODE == 0 ? 1024 : MODE == 1 ? AB_INP : MODE == 2 ? 2048 : 1024;
        for (int jj = 0; jj < cnt; ++jj) { const float pj = rdlane(p, jj);
            if (pj != 0.f) { const unsigned vv = *(const unsigned*)(vbase + (size_t)jj * VLD + 2 * lane); a0 += pj * bflo(vv); a1 += pj * bfhi(vv); } }
    }
    float inv;
    if (MODE == 1) { const float F2 = A.fg_[((size_t)m * 4 + h) * 2]; inv = 1.0f / fmaxf(fabsf(l), __builtin_amdgcn_exp2f(-(F2 + mrun))); }
    else inv = 1.0f / l;
    bf16* op = MODE == 0 ? A.mix_ + (size_t)m * 1024 + h * 128 : MODE == 1 ? A.hm_ + (size_t)m * 512 + h * 128 : MODE == 2 ? A.mix_ + (size_t)m * 1024 + h * 128 : A.ox_ + (size_t)m * 512 + h * 128;
    *(unsigned*)(op + 2 * lane) = pk2(a0 * inv, a1 * inv);
    LDS_WAIT(); asm volatile("" ::: "memory");
}
template <int MODE, int NH>
__device__ __forceinline__ void ph_attn_simple(const Frame& F, const AttnBufs& A) {
    LAS float* qs = (LAS float*)(F.lds + F.wave * 1024);
    for (int task = F.gw; task < M * NH; task += F.NGW) attn_task<MODE>(A, task / NH, task % NH, qs, F.lane);
}
namespace fa {
typedef short bf16x8 __attribute__((ext_vector_type(8)));
typedef short s16x4 __attribute__((ext_vector_type(4)));
typedef float f32x16 __attribute__((ext_vector_type(16)));
typedef unsigned u32x4 __attribute__((ext_vector_type(4)));
#define FA_KSWZ(row, colB) ((row) * 256 + ((colB) ^ (((row) & 7) << 4)))
#define FA_KSWZ2(row, colB) ((row) * 128 + ((colB) ^ (((row) & 7) << 4)))
#define FA_SBAR() __builtin_amdgcn_sched_barrier(0)
__device__ __forceinline__ int crow(int r, int hi) { return (r & 3) + 8 * (r >> 2) + 4 * hi; }
__device__ __forceinline__ unsigned cvtpk(float lo, float hi) { unsigned r; asm volatile("v_cvt_pk_bf16_f32 %0, %1, %2" : "=v"(r) : "v"(lo), "v"(hi)); return r; }
__device__ __forceinline__ int v_st(int k, int c) { const int kk = (k & ~0xC) | ((k & 4) << 1) | ((k & 8) >> 1); return ((kk >> 3) * 4 + (c >> 5)) * 512 + ((kk & 7) * 32 + (c & 31)) * 2; }
__device__ __forceinline__ int v_rd_base(int lane) { return ((lane & 3) << 3) | (((lane >> 2) & 3) << 6) | (((lane >> 4) & 1) << 5) | (((lane >> 5) & 1) << 8); }
constexpr int v_rd_off(int d0, int ks, int half) { return d0 * 512 + ks * 4096 + half * 2048; }
template <int OFF> __device__ __forceinline__ s16x4 tr_read(int vb) { s16x4 r; asm volatile("ds_read_b64_tr_b16 %0, %1 offset:%2" : "=&v"(r) : "v"(vb), "i"(OFF) : "memory"); return r; }
template <int D0> __device__ __forceinline__ void pv_one(f32x16& od, int vb, bf16x8 pa0, bf16x8 pa1, bf16x8 pa2, bf16x8 pa3) {
    const s16x4 l0 = tr_read<v_rd_off(D0, 0, 0)>(vb), h0 = tr_read<v_rd_off(D0, 0, 1)>(vb), l1 = tr_read<v_rd_off(D0, 1, 0)>(vb), h1 = tr_read<v_rd_off(D0, 1, 1)>(vb);
    const s16x4 l2 = tr_read<v_rd_off(D0, 2, 0)>(vb), h2 = tr_read<v_rd_off(D0, 2, 1)>(vb), l3 = tr_read<v_rd_off(D0, 3, 0)>(vb), h3 = tr_read<v_rd_off(D0, 3, 1)>(vb);
    asm volatile("s_waitcnt lgkmcnt(0)" ::: "memory"); FA_SBAR();
#define FA_PK(L, H) (bf16x8){L[0], L[1], L[2], L[3], H[0], H[1], H[2], H[3]}
    od = __builtin_amdgcn_mfma_f32_32x32x16_bf16(pa0, FA_PK(l0, h0), od, 0, 0, 0);
    od = __builtin_amdgcn_mfma_f32_32x32x16_bf16(pa1, FA_PK(l1, h1), od, 0, 0, 0);
    od = __builtin_amdgcn_mfma_f32_32x32x16_bf16(pa2, FA_PK(l2, h2), od, 0, 0, 0);
    od = __builtin_amdgcn_mfma_f32_32x32x16_bf16(pa3, FA_PK(l3, h3), od, 0, 0, 0);
#undef FA_PK
}
struct Args {
    const bf16* Q; int ldq;
    const bf16* K; int ldk;
    const bf16* K2; int ldk2;
    const bf16* V; int ldv;
    bf16* O; int ldo;
    int nt, diag0;
    const float* fg;
    int q0;
    const unsigned* bm;
};
constexpr float THR2 = 11.0f;
constexpr int LDS_V = 0, LDS_K = 32768, LDS_K2 = 65536, LDS_WS = 81920, LDS_GB = 83968, LDS_END = 84480;
template <int MODE>
__device__ __forceinline__ void unit(const Args& a, LAS unsigned char* lds, const int tid) {
    constexpr int NK = (MODE == 0) ? 12 : 8;
    const int wid = __builtin_amdgcn_readfirstlane(tid >> 6), lane = tid & 63, r32 = lane & 31, hi = lane >> 5;
    LAS unsigned char* V_lds = lds + LDS_V; LAS unsigned char* K_lds = lds + LDS_K; LAS unsigned char* K2_lds = lds + LDS_K2;
    LAS float* wsl = (LAS float*)(lds + LDS_WS) + wid * 64; LAS float* li_l = wsl; LAS float* al_l = wsl + 32; LAS float* gb = (LAS float*)(lds + LDS_GB);
    float m_reg = -1e30f, l_reg = 0.f; f32x16 o[4];
#pragma unroll
    for (int d = 0; d < 4; ++d)
#pragma unroll
        for (int r = 0; r < 16; ++r) o[d][r] = 0.f;
    bf16x8 qr[NK];
    { const bf16* Qw = a.Q + (size_t)(wid * 32 + r32) * a.ldq + hi * 8;
#pragma unroll
      for (int d0 = 0; d0 < NK; ++d0) qr[d0] = *(const bf16x8*)(Qw + d0 * 16); }
    const int sr = tid >> 4, sc = (tid & 15) * 8, vst0 = v_st(sr, sc), vst1 = v_st(32 + sr, sc), k2r = tid >> 3, k2c = (tid & 7) * 8;
    const int vb0 = (int)(unsigned)(size_t)V_lds + v_rd_base(lane);
    bf16x8 sv0, sv1, sk0, sk1, sk2; float sg = 0.f; unsigned bw0 = 0u, bw1 = 0u, nbw0 = 0u, nbw1 = 0u;
#define FA_SLOAD(j) do { const size_t k0_ = (size_t)(j) * 64; \
        sv0 = *(const bf16x8*)(a.V + (k0_ + sr) * a.ldv + sc); sv1 = *(const bf16x8*)(a.V + (k0_ + 32 + sr) * a.ldv + sc); \
        sk0 = *(const bf16x8*)(a.K + (k0_ + sr) * a.ldk + sc); sk1 = *(const bf16x8*)(a.K + (k0_ + 32 + sr) * a.ldk + sc); \
        if (MODE == 0) sk2 = *(const bf16x8*)(a.K2 + (k0_ + k2r) * a.ldk2 + k2c); \
        if (MODE == 1) { if (tid < 64) sg = a.fg[(k0_ + tid) * 8 + 1]; } \
        if (MODE == 2) { const unsigned long long w_ = *(const unsigned long long*)(a.bm + (size_t)(wid * 32 + r32) * 64 + 2 * (j)); nbw0 = (unsigned)w_; nbw1 = (unsigned)(w_ >> 32); } } while (0)
#define FA_SWRITE(b) do { *(LAS bf16x8*)(V_lds + (b) * 16384 + vst0) = sv0; *(LAS bf16x8*)(V_lds + (b) * 16384 + vst1) = sv1; \
        *(LAS bf16x8*)(K_lds + (b) * 16384 + FA_KSWZ(sr, sc * 2)) = sk0; *(LAS bf16x8*)(K_lds + (b) * 16384 + FA_KSWZ(32 + sr, sc * 2)) = sk1; \
        if (MODE == 0) *(LAS bf16x8*)(K2_lds + (b) * 8192 + FA_KSWZ2(k2r, k2c * 2)) = sk2; \
        if (MODE == 1) { if (tid < 64) gb[(b) * 64 + tid] = sg; } } while (0)
    const int NT = a.nt;
    FA_SLOAD(0); FA_SWRITE(0); bw0 = nbw0; bw1 = nbw1;
    __syncthreads();
    for (int j = 0; j < NT; ++j) {
        const int b = j & 1;
        if (j + 1 < NT) FA_SLOAD(j + 1);
        f32x16 p0, p1;
#pragma unroll
        for (int r = 0; r < 16; ++r) { p0[r] = 0.f; p1[r] = 0.f; }
        { const LAS unsigned char* Ks = K_lds + b * 16384;
#pragma unroll
          for (int d0 = 0; d0 < 8; ++d0) { const int cb = (d0 * 16 + hi * 8) * 2;
              const bf16x8 b0 = *(const LAS bf16x8*)(Ks + FA_KSWZ(r32, cb)), b1 = *(const LAS bf16x8*)(Ks + FA_KSWZ(32 + r32, cb));
              p0 = __builtin_amdgcn_mfma_f32_32x32x16_bf16(b0, qr[d0], p0, 0, 0, 0); p1 = __builtin_amdgcn_mfma_f32_32x32x16_bf16(b1, qr[d0], p1, 0, 0, 0); }
          if (MODE == 0) { const LAS unsigned char* K2s = K2_lds + b * 8192;
#pragma unroll
              for (int d0 = 0; d0 < 4; ++d0) { const int cb = (d0 * 16 + hi * 8) * 2;
                  const bf16x8 b0 = *(const LAS bf16x8*)(K2s + FA_KSWZ2(r32, cb)), b1 = *(const LAS bf16x8*)(K2s + FA_KSWZ2(32 + r32, cb));
                  p0 = __builtin_amdgcn_mfma_f32_32x32x16_bf16(b0, qr[(MODE == 0) ? 8 + d0 : 0], p0, 0, 0, 0); p1 = __builtin_amdgcn_mfma_f32_32x32x16_bf16(b1, qr[(MODE == 0) ? 8 + d0 : 0], p1, 0, 0, 0); } } }
        f32x16 x0, x1;
        if (MODE == 1) {
#pragma unroll
            for (int q4 = 0; q4 < 4; ++q4) { const f32x4 g0 = *(const LAS f32x4*)(gb + b * 64 + 8 * q4 + 4 * hi), g1 = *(const LAS f32x4*)(gb + b * 64 + 32 + 8 * q4 + 4 * hi);
#pragma unroll
                for (int e = 0; e < 4; ++e) { x0[4 * q4 + e] = g0[e]; x1[4 * q4 + e] = g1[e]; } }
        } else { x0 = p0; x1 = p1; }
        const float NEG = -__builtin_inff();
        if (MODE == 0 || MODE == 1) { if (j >= a.diag0) { const int dq = wid * 32 + r32 - 64 * (j - a.diag0) - 4 * hi;
#pragma unroll
                for (int r = 0; r < 16; ++r) { const int c = (r & 3) + 8 * (r >> 2); if (c > dq) x0[r] = NEG; if (c + 32 > dq) x1[r] = NEG; } } }
        if (MODE == 2) { const unsigned w0 = bw0 >> (4 * hi), w1 = bw1 >> (4 * hi);
#pragma unroll
            for (int r = 0; r < 16; ++r) { const int c = (r & 3) + 8 * (r >> 2); if (!((w0 >> c) & 1u)) x0[r] = NEG; if (!((w1 >> c) & 1u)) x1[r] = NEG; } }
        float pmax = x0[0];
#pragma unroll
        for (int r = 1; r < 16; ++r) pmax = fmaxf(pmax, x0[r]);
#pragma unroll
        for (int r = 0; r < 16; ++r) pmax = fmaxf(pmax, x1[r]);
        { const auto rr = __builtin_amdgcn_permlane32_swap(__float_as_uint(pmax), __float_as_uint(pmax), false, false); pmax = fmaxf(__uint_as_float(rr[0]), __uint_as_float(rr[1])); }
        float mn, alpha;
        if (__all(pmax - m_reg <= THR2)) { mn = m_reg; alpha = 1.f; }
        else { mn = fmaxf(m_reg, pmax); alpha = __builtin_amdgcn_exp2f(m_reg - mn); m_reg = mn; }
#pragma unroll
        for (int r = 0; r < 16; ++r) { x0[r] = __builtin_amdgcn_exp2f(x0[r] - mn); x1[r] = __builtin_amdgcn_exp2f(x1[r] - mn); }
        if (MODE == 1) {
#pragma unroll
            for (int r = 0; r < 16; ++r) { x0[r] *= p0[r]; x1[r] *= p1[r]; } }
        float ps = 0.f;
#pragma unroll
        for (int r = 0; r < 16; ++r) ps += x0[r] + x1[r];
        { const auto rr = __builtin_amdgcn_permlane32_swap(__float_as_uint(ps), __float_as_uint(ps), false, false); ps = __uint_as_float(rr[0]) + __uint_as_float(rr[1]); }
        l_reg = l_reg * alpha + ps;
        bf16x8 pa0, pa1, pa2, pa3;
#define FA_PK4(P, BASE, OUT) do { const unsigned a0_ = cvtpk(P[BASE + 0], P[BASE + 1]), a1_ = cvtpk(P[BASE + 2], P[BASE + 3]), b0_ = cvtpk(P[BASE + 4], P[BASE + 5]), b1_ = cvtpk(P[BASE + 6], P[BASE + 7]); \
        const auto r0_ = __builtin_amdgcn_permlane32_swap(a0_, b0_, false, false); const auto r1_ = __builtin_amdgcn_permlane32_swap(a1_, b1_, false, false); \
        u32x4 w_ = {r0_[0], r1_[0], r0_[1], r1_[1]}; OUT = *reinterpret_cast<bf16x8*>(&w_); } while (0)
        FA_PK4(x0, 0, pa0); FA_PK4(x0, 8, pa1); FA_PK4(x1, 0, pa2); FA_PK4(x1, 8, pa3);
#undef FA_PK4
        if (__any(alpha < 1.f)) { if (hi == 0) al_l[r32] = alpha; asm volatile("s_waitcnt lgkmcnt(0)" ::: "memory");
#pragma unroll
            for (int q4 = 0; q4 < 4; ++q4) { const f32x4 av = *(const LAS f32x4*)(al_l + 8 * q4 + 4 * hi);
#pragma unroll
                for (int d = 0; d < 4; ++d) { o[d][4 * q4 + 0] *= av[0]; o[d][4 * q4 + 1] *= av[1]; o[d][4 * q4 + 2] *= av[2]; o[d][4 * q4 + 3] *= av[3]; } } }
        { const int vb = vb0 + b * 16384; pv_one<0>(o[0], vb, pa0, pa1, pa2, pa3); pv_one<1>(o[1], vb, pa0, pa1, pa2, pa3); pv_one<2>(o[2], vb, pa0, pa1, pa2, pa3); pv_one<3>(o[3], vb, pa0, pa1, pa2, pa3); }
        if (j + 1 < NT) { FA_SWRITE((j + 1) & 1); bw0 = nbw0; bw1 = nbw1; }
        __syncthreads();
    }
    { float den = l_reg;
      if (MODE == 1) { const float F2 = a.fg[(size_t)(a.q0 + wid * 32 + r32) * 8]; den = fmaxf(fabsf(l_reg), __builtin_amdgcn_exp2f(-(F2 + m_reg))); }
      if (hi == 0) li_l[r32] = __builtin_amdgcn_rcpf(den);
      asm volatile("s_waitcnt lgkmcnt(0)" ::: "memory");
      bf16* Ow = a.O + (size_t)(wid * 32) * a.ldo;
#pragma unroll
      for (int q4 = 0; q4 < 4; ++q4) { const f32x4 rl = *(const LAS f32x4*)(li_l + 8 * q4 + 4 * hi);
#pragma unroll
          for (int e = 0; e < 4; ++e) { const int orow = 8 * q4 + 4 * hi + e;
#pragma unroll
              for (int d = 0; d < 4; ++d) Ow[(size_t)orow * a.ldo + d * 32 + r32] = (bf16)f2bf(o[d][4 * q4 + e] * rl[e]); } } }
    __syncthreads();
#undef FA_SLOAD
#undef FA_SWRITE
}
}
constexpr int IDX_LD = 2052;
typedef short idx_bf16x8 __attribute__((ext_vector_type(8)));
__device__ __forceinline__ void ph_indexer_mfma(const Frame& F, const bf16* U, unsigned* BM) {
    const int lane = F.lane, w = F.wave, tok = lane & 15, rq = lane >> 4;
    LAS float* sc = (LAS float*)F.lds;
    const int vcu = (F.G % 8 == 0) ? ((int)blockIdx.x % 8) * (F.G / 8) + (int)blockIdx.x / 8 : (int)blockIdx.x;
    for (int uu = vcu; uu < 512; uu += F.G) {
        for (int s2 = 0; s2 < 2; ++s2) {
            const int pr = uu & 255, hb = uu >> 8;
            const int bq = hb * 4 + (pr >> 6), ui = pr & 63;
            const int un = s2 ? 127 - ui : ui;
            const int t0 = 16 * un; const size_t kb = (size_t)bq * SEQ;
            if (t0 + 15 <= 255) {
                for (int tt = 2 * w; tt < 2 * w + 2; ++tt) { const int t = t0 + tt; const int n = t + 1 - 32 * lane;
                    BM[(kb + t) * 64 + lane] = n >= 32 ? 0xffffffffu : (n > 0 ? ((1u << n) - 1u) : 0u); }
                continue; }
            idx_bf16x8 qf[8][2]; float wi[8];
            { const bf16* qrow = U + (kb + t0 + tok) * C_INP + V_QI;
#pragma unroll
              for (int h = 0; h < 8; ++h)
#pragma unroll
                  for (int ks = 0; ks < 2; ++ks) qf[h][ks] = *(const idx_bf16x8*)(qrow + h * 64 + ks * 32 + rq * 8);
              float v[8]; unpack8(*(const v4u*)(U + (kb + t0 + tok) * C_INP + V_WI), v);
#pragma unroll
              for (int h = 0; h < 8; ++h) wi[h] = v[h]; }
            const int nkb = un + 1;
            idx_bf16x8 ka0, ka1, na0, na1;
            if (w < nkb) { const bf16* kr = U + (kb + 16 * w + tok) * C_INP + V_KI + rq * 8; ka0 = *(const idx_bf16x8*)kr; ka1 = *(const idx_bf16x8*)(kr + 32); }
            for (int kblk = w; kblk < nkb; kblk += 8) {
                if (kblk + 8 < nkb) { const bf16* kr = U + (kb + 16 * (kblk + 8) + tok) * C_INP + V_KI + rq * 8; na0 = *(const idx_bf16x8*)kr; na1 = *(const idx_bf16x8*)(kr + 32); }
                f32x4 acc = {0.f, 0.f, 0.f, 0.f};
#pragma unroll
                for (int h = 0; h < 8; ++h) { f32x4 d = {0.f, 0.f, 0.f, 0.f};
                    d = __builtin_amdgcn_mfma_f32_16x16x32_bf16(ka0, qf[h][0], d, 0, 0, 0); d = __builtin_amdgcn_mfma_f32_16x16x32_bf16(ka1, qf[h][1], d, 0, 0, 0);
                    acc[0] += fmaxf(d[0], 0.f) * wi[h]; acc[1] += fmaxf(d[1], 0.f) * wi[h]; acc[2] += fmaxf(d[2], 0.f) * wi[h]; acc[3] += fmaxf(d[3], 0.f) * wi[h]; }
                *(LAS f32x4*)(sc + tok * IDX_LD + 16 * kblk + 4 * rq) = acc;
                ka0 = na0; ka1 = na1;
            }
            __syncthreads();
            for (int tt = 2 * w; tt < 2 * w + 2; ++tt) { const int t = t0 + tt; topk_bitmap(sc + tt * IDX_LD, t, BM + (kb + t) * 64, lane); }
            __syncthreads();
        }
    }
}
#ifndef IDX_MFMA
#define IDX_MFMA 1
#endif
#ifndef REP_ATTN
#define REP_ATTN 1
#endif
#ifndef REP_IDX
#define REP_IDX 1
#endif
#ifndef REP_GEMM
#define REP_GEMM 1
#endif
#ifndef REP_BAR
#define REP_BAR 1
#endif
#ifndef FA_MLA
#define FA_MLA 1
#endif
#ifndef FA_MLSTM
#define FA_MLSTM 1
#endif
#ifndef FA_DSA
#define FA_DSA 1
#endif
#ifndef FA_CROSS
#define FA_CROSS 1
#endif
template <class Epi>
__device__ __forceinline__ void run_gemm(const Frame& F, const bf16* A, const bf16* Bt, int Mr, int N, int K, const Epi& E, int crot) {
    pg8::Gemm g{A, Bt, Mr, N, K}; pg8::StaticOrder S; int c = (int)blockIdx.x - crot; if (c < 0) c += F.G; S.init(Mr, N, F.G, c);
    _Pragma("unroll") for (int rep_ = 0; rep_ < REP_GEMM; ++rep_) pg8::gemm_phase<Epi, pg8::StaticOrder, true, true>(F.lds, g, S, E, F.wave);
}

typedef const float* cfptr;
__device__ __forceinline__ cfptr inp_ptr(int i) {
    unsigned long long ka = (unsigned long long)__builtin_amdgcn_kernarg_segment_ptr(); asm volatile("" : "+s"(ka));
    const unsigned long long v = ((const __attribute__((address_space(4))) unsigned long long*)ka)[i];
    return (cfptr)(const __attribute__((address_space(1))) float*)v;
}
#define INP(i) inp_ptr(i)
__global__ void __launch_bounds__(NWAVES * 64, 2) mega_fwd(Params P) {
    extern __shared__ __attribute__((aligned(16))) unsigned char lds_raw[];
    const int wave_s = __builtin_amdgcn_readfirstlane((int)threadIdx.x >> 6);
#define MK_FRAME() Frame F; unsigned char* ws = P.ws; asm volatile("" : "+s"(ws)); { int l_o; asm volatile("v_mbcnt_lo_u32_b32 %0, -1, 0\n\tv_mbcnt_hi_u32_b32 %0, -1, %0" : "=v"(l_o)); F.lds = (LAS unsigned char*)lds_raw; F.lane = l_o; F.wave = wave_s; F.tid = wave_s * 64 + l_o; \
    F.G = gridDim.x; F.gw = blockIdx.x * NWAVES + F.wave; F.NGW = F.G * NWAVES; }
    MK_FRAME();
    for (int u = F.tid; u < (LDS_BYTES - LDSCTL_OFF) / 4; u += NWAVES * 64) ((LAS unsigned*)(F.lds + LDSCTL_OFF))[u] = 0u;
    __syncthreads();
    XcdBarrier bar = xcd_barrier_post((unsigned*)(ws + WS_CTL) + CW_BAR, (volatile LAS unsigned*)(F.lds + MISC_OFF) + 8);
    const int lo = P.st_lo, hi = P.st_hi; int step = 0;
#define STEP_BEGIN if (step >= lo && step < hi) { MK_FRAME();
#define STEP_END if (step + 1 < hi) { _Pragma("unroll") for (int rb_ = 0; rb_ < REP_BAR; ++rb_) xcd_barrier(bar); } } ++step;

#define WGU ((bf16*)(ws + WS_WGU))
#define WDN ((bf16*)(ws + WS_WDN))
#define WXQ ((bf16*)(ws + WS_WXQ))
#define WXKV ((bf16*)(ws + WS_WXKV))
#define WXO ((bf16*)(ws + WS_WXO))
#define WIN ((bf16*)(ws + WS_WIN))
#define WOUT ((bf16*)(ws + WS_WOUT))
#define WUQ ((bf16*)(ws + WS_WUQ))
#define WUKV ((bf16*)(ws + WS_WUKV))
#define WQK ((bf16*)(ws + WS_WQK))
#define WGEFF ((float*)(ws + WS_WGEFF))
#define MEMN ((bf16*)(ws + WS_MEMN))
#define KVX ((bf16*)(ws + WS_KVX))
#define ROPE ((float*)(ws + WS_ROPE))
#define XB ((bf16*)(ws + WS_XB))
#define Y ((bf16*)(ws + WS_Y))
#define ACT ((bf16*)(ws + WS_ACT))
#define U ((bf16*)(ws + WS_U))
#define CQN ((bf16*)(ws + WS_CQN))
#define CKVN ((bf16*)(ws + WS_CKVN))
#define KR ((bf16*)(ws + WS_KR))
#define XC ((bf16*)(ws + WS_XC))
#define GATE ((float*)(ws + WS_GATE))
#define FG ((float*)(ws + WS_FG))
#define QA ((bf16*)(ws + WS_QA))
#define KVA ((bf16*)(ws + WS_KVA))
#define QKM ((bf16*)(ws + WS_QKM))
#define HM ((bf16*)(ws + WS_HM))
#define MIX ((bf16*)(ws + WS_MIX))
#define BM ((unsigned*)(ws + WS_BM))
#define QX ((bf16*)(ws + WS_QX))
#define OX ((bf16*)(ws + WS_OX))
#define X (P.out)
#define MK_AB() AttnBufs AB; AB.qa_ = QA; AB.kva_ = KVA; AB.kr_ = KR; AB.qkm_ = QKM; AB.u_ = U; AB.qd_ = QA; AB.kvd_ = KVA; AB.qx_ = QX; AB.kvx_ = KVX; AB.fg_ = FG; AB.bm_ = BM; AB.mix_ = MIX; AB.hm_ = HM; AB.ox_ = OX;
    STEP_BEGIN
        t_norm(F, INP(I_X), X, nullptr, 0.f, nullptr, INP(I_NORMG), XB);
        t_rope_table(F, (const int*)INP(I_POS), ROPE);
    STEP_END

    for (int it = 0; it < 2 * DEPTH; ++it) {
        const int l = it >> 1, f = it & 1, par = l & 1, e = l >> 1;
        const float* ng = INP(I_NORMG) + (size_t)l * 8 * DM;
        if (f == 0) {
            STEP_BEGIN
                int cur = 0;
                for (int ff = 0; ff < 2; ++ff) { const size_t wo = ((size_t)l * 2 + ff) * DM * FFN;
                    conv_mat(F, cur, INP(I_WG) + wo, DM, FFN, FFN, WGU + (size_t)ff * 5632 * DM, DM, 0, 1.f, MapGU{0});
                    conv_mat(F, cur, INP(I_WU) + wo, DM, FFN, FFN, WGU + (size_t)ff * 5632 * DM, DM, 0, 1.f, MapGU{128});
                    conv_mat(F, cur, INP(I_WD) + wo, FFN, DM, DM, WDN + (size_t)ff * DM * FFN, FFN, 0, 1.f, MapId{0}); }
                conv_mat(F, cur, INP(I_XQ) + (size_t)l * DM * 512, DM, 512, 512, WXQ, DM, 0, 1.f, MapId{0});
                conv_mat(F, cur, INP(I_XK) + (size_t)l * DM * 512, DM, 512, 512, WXKV, DM, 0, 1.f, MapId{0});
                conv_mat(F, cur, INP(I_XV) + (size_t)l * DM * 512, DM, 512, 512, WXKV, DM, 0, 1.f, MapId{512});
                conv_mat(F, cur, INP(I_XO) + (size_t)l * 512 * DM, 512, DM, DM, WXO, 512, 0, 1.f, MapId{0});
                t_memn(F, INP(I_MEM), INP(I_MEMG) + (size_t)l * DM, MEMN);
                if (par == 0) {
                    conv_mat(F, cur, INP(I_ABIN) + (size_t)e * DM * AB_IN, DM, AB_IN, AB_IN, WIN, DM, 0, 1.f, MapId{0});
                    zero_bytes(F, WIN + (size_t)AB_IN * DM, (size_t)(AB_INP - AB_IN) * DM * 2);
                    conv_mat(F, cur, INP(I_ABOUT) + (size_t)e * DM * DM, DM, DM, DM, WOUT, DM, 0, 1.f, MapId{0});
                    conv_mat(F, cur, INP(I_AUQ) + (size_t)e * 384 * 768, 384, 768, 768, WUQ, 384, 0, 1.f, MapRopeQ{});
                    conv_mat(F, cur, INP(I_AUKV) + (size_t)e * 256 * 1024, 256, 1024, 1024, WUKV, 256, 0, 1.f, MapId{0});
                    for (int h = 0; h < 4; ++h) {
                        conv_mat(F, cur, INP(I_MLWQ) + ((size_t)e * 4 + h) * 128 * 128, 128, 128, 128, WQK, 512, h * 128, 1.f, MapId{h * 128});
                        conv_mat(F, cur, INP(I_MLWK) + ((size_t)e * 4 + h) * 128 * 128, 128, 128, 128, WQK, 512, h * 128, 0.08838834764831845f, MapId{512 + h * 128}); }
                    for (int idx = blockIdx.x * 512 + F.tid; idx < 1024 * 48; idx += F.G * 512) { const int row = idx / 48, ch = idx % 48, hh = (row & 511) >> 7; int col = ch * 8; if (col >= hh * 128) col += 128;
                        unsigned zz = 0u; asm volatile("" : "+v"(zz)); *(v4u*)(WQK + (size_t)row * 512 + col) = (v4u){zz, zz, zz, zz}; }
                    t_weff(F, INP(I_MLWQ) + (size_t)e * 4 * 128 * 128, INP(I_MLWK) + (size_t)e * 4 * 128 * 128, INP(I_WGATES) + (size_t)e * 1536 * 8, WGEFF);
                } else {
                    conv_mat(F, cur, INP(I_CIN) + (size_t)e * DM * C_IN, DM, C_IN, C_IN, WIN, DM, 0, 1.f, MapId{0});
                    zero_bytes(F, WIN + (size_t)1248 * DM, (size_t)(C_INP - 1248) * DM * 2);
                    conv_mat(F, cur, INP(I_COUT) + (size_t)e * DM * DM, DM, DM, DM, WOUT, DM, 0, 1.f, MapId{0});
                    conv_mat(F, cur, INP(I_CUQ) + (size_t)e * 384 * 1024, 384, 1024, 1024, WUQ, 384, 0, 1.f, MapId{0});
                    for (int h = 0; h < 8; ++h) {
                        conv_mat(F, cur, INP(I_CUK) + ((size_t)e * 8 + h) * 256 * 128, 256, 128, 128, WUKV, 256, 0, 1.f, MapId{h * 128});
                        conv_mat(F, cur, INP(I_CUV) + ((size_t)e * 8 + h) * 256 * 128, 256, 128, 128, WUKV, 256, 0, 1.f, MapId{1024 + h * 128}); }
                }
            STEP_END
        }
        STEP_BEGIN
            run_gemm(F, XB, WGU + (size_t)f * 5632 * DM, M, 5632, DM, pg8::EpiSwiglu{ACT, FFN}, 0);
            if (f == 0) run_gemm(F, MEMN, WXKV, MROWS, 1024, DM, pg8::EpiPlain{KVX, 1024, 1.f}, 128);
        STEP_END
        STEP_BEGIN
            run_gemm(F, ACT, WDN + (size_t)f * DM * FFN, M, DM, FFN, pg8::EpiPlain{Y, DM, 1.f}, 0);
        STEP_END
        STEP_BEGIN
            const float* gpost = ng + (f == 0 ? 1 : 7) * DM;
            const float* gpre = f == 0 ? ng + 2 * DM : (l + 1 < DEPTH ? ng + 8 * DM : nullptr);
            t_norm(F, X, X, Y, 0.5f, gpost, gpre, XB);
        STEP_END
        if (f == 0) {
            STEP_BEGIN
                if (par == 0) run_gemm(F, XB, WIN, M, AB_INP, DM, pg8::EpiPlain{U, AB_INP, 1.f}, 0);
                else run_gemm(F, XB, WIN, M, C_INP, DM, pg8::EpiPlain{U, C_INP, 1.f}, 0);
            STEP_END
            STEP_BEGIN
                if (par == 0) t_prep_even(F, U, INP(I_ACQG) + (size_t)e * 384, INP(I_ACKVG) + (size_t)e * 256, ROPE, INP(I_CONVW) + (size_t)e * 4 * 512, INP(I_CONVB) + (size_t)e * 512,
                                          WGEFF, INP(I_BGATES) + (size_t)e * 8, CQN, CKVN, KR, XC, GATE);
                else t_prep_odd(F, U, INP(I_CCQG) + (size_t)e * 384, INP(I_CCKVG) + (size_t)e * 256, CQN, CKVN);
            STEP_END
            STEP_BEGIN
                if (par == 0) {
                    if (blockIdx.x < 32 && F.wave == 0) t_scan(F, GATE, FG, (int)blockIdx.x);
                    run_gemm(F, CQN, WUQ, M, 768, 384, pg8::EpiRopeQ{QA, 768, 0.07216878364870323f * LOG2E, ROPE}, 0);
                    run_gemm(F, CKVN, WUKV, M, 1024, 256, pg8::EpiPlain{KVA, 1024, 1.f}, 0);
                    run_gemm(F, XC, WQK, M, 1024, 512, pg8::EpiPlain{QKM, 1024, 1.f}, 0);
                } else {
                    run_gemm(F, CQN, WUQ, M, 1024, 384, pg8::EpiPlain{QA, 1024, 0.08838834764831845f * LOG2E}, 0);
                    run_gemm(F, CKVN, WUKV, M, 2048, 256, pg8::EpiPlain{KVA, 2048, 1.f}, 0);
                }
            STEP_END
            if (par == 1) {
                STEP_BEGIN
                    #if IDX_MFMA
                    ph_indexer_mfma(F, U, BM);
#else
                    ph_indexer_simple(F, U, BM);
#endif
                STEP_END
            }
            STEP_BEGIN
                MK_AB(); const int vcu = (F.G % 8 == 0) ? ((int)blockIdx.x % 8) * (F.G / 8) + (int)blockIdx.x / 8 : (int)blockIdx.x;
                if (par == 0) {
#if FA_MLA
                    for (int u = vcu; u < 256; u += F.G) { const int bh = u >> 3, qb = u & 7, b = bh >> 2, h = bh & 3; const size_t kb = (size_t)b * SEQ, m0 = kb + 256 * qb;
                        fa::Args a; a.Q = QA + m0 * 768 + h * 192; a.ldq = 768; a.K = KVA + kb * 1024 + h * 256; a.ldk = 1024; a.K2 = KR + kb * 64; a.ldk2 = 64; a.V = KVA + kb * 1024 + h * 256 + 128; a.ldv = 1024;
                        a.O = MIX + m0 * 1024 + h * 128; a.ldo = 1024; a.nt = 4 * (qb + 1); a.diag0 = 4 * qb; a.fg = nullptr; a.q0 = 0; a.bm = nullptr;
                        _Pragma("unroll") for (int ra_ = 0; ra_ < REP_ATTN; ++ra_) fa::unit<0>(a, F.lds, F.tid); }
#else
                    ph_attn_simple<0, 4>(F, AB);
#endif
#if FA_MLSTM
                    for (int u = vcu; u < 256; u += F.G) { const int bh = u >> 3, qb = 7 - (u & 7), b = bh >> 2, h = bh & 3; const size_t kb = (size_t)b * SEQ, m0 = kb + 256 * qb;
                        fa::Args a; a.Q = QKM + m0 * 1024 + h * 128; a.ldq = 1024; a.K = QKM + kb * 1024 + 512 + h * 128; a.ldk = 1024; a.K2 = nullptr; a.ldk2 = 0; a.V = U + kb * AB_INP + U_VM + h * 128; a.ldv = AB_INP;
                        a.O = HM + m0 * 512 + h * 128; a.ldo = 512; a.nt = 4 * (qb + 1); a.diag0 = 4 * qb; a.fg = FG + kb * 8 + h * 2; a.q0 = 256 * qb; a.bm = nullptr;
                        _Pragma("unroll") for (int ra_ = 0; ra_ < REP_ATTN; ++ra_) fa::unit<1>(a, F.lds, F.tid); }
#else
                    ph_attn_simple<1, 4>(F, AB);
#endif
                } else {
#if FA_DSA
                    for (int u = vcu; u < 256; u += F.G) { const int bh = u >> 2, pi = u & 3, b = bh >> 3, h = bh & 7; const size_t kb = (size_t)b * SEQ;
                        for (int s2 = 0; s2 < 2; ++s2) { const int qb = s2 ? 7 - pi : pi; const size_t m0 = kb + 256 * qb;
                            fa::Args a; a.Q = QA + m0 * 1024 + h * 128; a.ldq = 1024; a.K = KVA + kb * 2048 + h * 128; a.ldk = 2048; a.K2 = nullptr; a.ldk2 = 0; a.V = KVA + kb * 2048 + 1024 + h * 128; a.ldv = 2048;
                            a.O = MIX + m0 * 1024 + h * 128; a.ldo = 1024; a.nt = 4 * (qb + 1); a.diag0 = 4 * qb; a.fg = nullptr; a.q0 = 0; a.bm = BM + m0 * 64;
                            _Pragma("unroll") for (int ra_ = 0; ra_ < REP_ATTN; ++ra_) fa::unit<2>(a, F.lds, F.tid); } }
#else
                    ph_attn_simple<2, 8>(F, AB);
#endif
                }
            STEP_END
            if (par == 0) {
                STEP_BEGIN
                    t_mix(F, HM, XC, U, INP(I_GNG) + (size_t)e * 512, INP(I_SKIP) + (size_t)e * 512, MIX);
                STEP_END
            }
            STEP_BEGIN
                run_gemm(F, MIX, WOUT, M, DM, DM, pg8::EpiPlain{Y, DM, 1.f}, 0);
            STEP_END
            STEP_BEGIN
                t_norm(F, X, X, Y, 1.0f, ng + 3 * DM, ng + 4 * DM, XB);
            STEP_END
            STEP_BEGIN
                run_gemm(F, XB, WXQ, M, 512, DM, pg8::EpiPlain{QX, 512, 0.08838834764831845f * LOG2E}, 0);
            STEP_END
            STEP_BEGIN
#if FA_CROSS
                const int vcu = (F.G % 8 == 0) ? ((int)blockIdx.x % 8) * (F.G / 8) + (int)blockIdx.x / 8 : (int)blockIdx.x;
                for (int u = vcu; u < 256; u += F.G) { const int bh = u >> 3, qb = u & 7, b = bh >> 2, h = bh & 3; const size_t m0 = (size_t)b * SEQ + 256 * qb, kr0 = (size_t)b * NMEM;
                    fa::Args a; a.Q = QX + m0 * 512 + h * 128; a.ldq = 512; a.K = KVX + kr0 * 1024 + h * 128; a.ldk = 1024; a.K2 = nullptr; a.ldk2 = 0; a.V = KVX + kr0 * 1024 + 512 + h * 128; a.ldv = 1024;
                    a.O = OX + m0 * 512 + h * 128; a.ldo = 512; a.nt = 4; a.diag0 = 1 << 20; a.fg = nullptr; a.q0 = 0; a.bm = nullptr;
                    _Pragma("unroll") for (int ra_ = 0; ra_ < REP_ATTN; ++ra_) fa::unit<3>(a, F.lds, F.tid); }
#else
                MK_AB(); ph_attn_simple<3, 4>(F, AB);
#endif
            STEP_END
            STEP_BEGIN
                run_gemm(F, OX, WXO, M, DM, 512, pg8::EpiPlain{Y, DM, 1.f}, 0);
            STEP_END
            STEP_BEGIN
                t_norm(F, X, X, Y, 1.0f, ng + 5 * DM, ng + 6 * DM, XB);
            STEP_END
        }
    }
#undef STEP_BEGIN
#undef STEP_END
}

#ifndef MK_SPLIT
#define MK_SPLIT 0
#endif
constexpr int N_STEPS = 1 + DEPTH * (1 + 3 + 3 + 1 + 1 + 2 + 4 + 3) - 2;
extern "C" void kernel_launch(void* const* d_in, const int* in_sizes, int n_in, void* d_out, int out_size, void* d_ws, size_t ws_size, hipStream_t stream) {
    static int grid = 0;
    if (grid == 0) {
        if (n_in != 33 || in_sizes[0] != M * DM || out_size != M * DM || ws_size < WS_END) { fprintf(stderr, "kernel_launch: unexpected shapes (n_in %d, in0 %d, out %d, ws %zu < %zu)\n", n_in, n_in > 0 ? in_sizes[0] : -1, out_size, ws_size, (size_t)WS_END); grid = -1; return; }
        int dev = 0, cus = 0;
        if (hipGetDevice(&dev) != hipSuccess || hipDeviceGetAttribute(&cus, hipDeviceAttributeMultiprocessorCount, dev) != hipSuccess) { grid = -1; return; }
        if (hipFuncSetAttribute((const void*)mega_fwd, hipFuncAttributeMaxDynamicSharedMemorySize, LDS_BYTES) != hipSuccess) { fprintf(stderr, "kernel_launch: hipFuncSetAttribute failed\n"); grid = -1; return; }
        int per_cu = 0;
        if (hipOccupancyMaxActiveBlocksPerMultiprocessor(&per_cu, (const void*)mega_fwd, NWAVES * 64, LDS_BYTES) != hipSuccess || per_cu < 1) fprintf(stderr, "kernel_launch: occupancy query says %d\n", per_cu);
        (void)hipGetLastError();
        grid = cus;
    }
    if (grid < 0) return;
    Params p{};
    for (int i = 0; i < 33; ++i) p.in[i] = (const float*)d_in[i];
    p.out = (float*)d_out; p.ws = (unsigned char*)d_ws;
#if MK_SPLIT
    for (int s = 0; s < 200; ++s) { (void)hipMemsetAsync((char*)d_ws + WS_CTL, 0, CTL_BYTES, stream); p.st_lo = s; p.st_hi = s + 1; hipLaunchKernelGGL(mega_fwd, dim3(grid), dim3(NWAVES * 64), LDS_BYTES, stream, p); if (s + 1 >= N_STEPS) break; }
#else
    (void)hipMemsetAsync((char*)d_ws + WS_CTL, 0, CTL_BYTES, stream);
    p.st_lo = 0; p.st_hi = 1 << 20;
    hipLaunchKernelGGL(mega_fwd, dim3(grid), dim3(NWAVES * 64), LDS_BYTES, stream, p);
#endif
    const hipError_t le = hipPeekAtLastError();
    if (le != hipSuccess) fprintf(stderr, "kernel_launch: launch failed: %s\n", hipGetErrorName(le));
}
```
